# Optimizing an MI355X kernel written in HIP

```python
import jax, jax.numpy as jnp
from jax import lax
import numpy as np

D_MODEL = 1024
BATCH = 8
SEQ = 4096
DEPTH = 4

N_MIXERS = 3
SB_HEADS = 16
SB_HEAD_DIM = D_MODEL // SB_HEADS
SB_Q_BLOCK = 128
CONV_WIDTH = 3
GLA_HEADS = 4
GLA_DK = D_MODEL // 2
GLA_DV = D_MODEL
GLA_DK_HEAD = GLA_DK // GLA_HEADS
GLA_DV_HEAD = GLA_DV // GLA_HEADS
GLA_GATE_RANK = 16
GLA_GATE_NORMALIZER = 16.0
GLA_CHUNK = 64
D_FF = 4 * D_MODEL
RMS_EPS = 1e-6

kernel_name = "hybrid_sb_conv_gla_sqrelu_sandwich"


def rms_norm(x, gain):
    xf = x.astype(jnp.float32)
    y = xf * lax.rsqrt(jnp.mean(xf * xf, axis=-1, keepdims=True) + RMS_EPS) * gain.astype(jnp.float32)
    return y.astype(x.dtype)


def stick_breaking_mixer(xn, w_qkv, w_o):
    b, s, _ = xn.shape
    qkv = (xn @ w_qkv).reshape(b, s, 3, SB_HEADS, SB_HEAD_DIM)
    q, k, v = [qkv[:, :, i].transpose(0, 2, 1, 3).astype(jnp.float32) for i in range(3)]
    scale = SB_HEAD_DIM ** -0.5
    n_blocks = s // SB_Q_BLOCK
    q_blocks = q.reshape(b, SB_HEADS, n_blocks, SB_Q_BLOCK, SB_HEAD_DIM).transpose(2, 0, 1, 3, 4)
    key_pos = jnp.arange(s)

    def one_block(args):
        qb, start = args
        z = jnp.einsum('bhqd,bhkd->bhqk', qb, k) * scale
        q_pos = start + jnp.arange(SB_Q_BLOCK)
        mask = key_pos[None, :] < q_pos[:, None]
        log_beta = jax.nn.log_sigmoid(z)
        log_1m_beta = jnp.where(mask, jax.nn.log_sigmoid(-z), 0.0)
        suffix = lax.cumsum(log_1m_beta, axis=3, reverse=True) - log_1m_beta
        weights = jnp.where(mask, jnp.exp(log_beta + suffix), 0.0)
        return jnp.einsum('bhqk,bhkd->bhqd', weights, v)

    o = lax.map(one_block, (q_blocks, jnp.arange(n_blocks) * SB_Q_BLOCK))
    o = o.transpose(1, 0, 3, 2, 4).reshape(b, s, D_MODEL).astype(xn.dtype)
    return o @ w_o


def short_conv_mixer(xn, w_in, conv_w, w_out):
    s = xn.shape[1]
    bcu = xn @ w_in
    b_gate, c_gate, u = jnp.split(bcu, 3, axis=-1)
    h = c_gate * u
    hp = jnp.pad(h, ((0, 0), (CONV_WIDTH - 1, 0), (0, 0)))
    conv = sum(conv_w[i] * hp[:, i:i + s] for i in range(CONV_WIDTH))
    return (b_gate * conv) @ w_out


def gla_mixer(xn, w_in, w_gate_up, b_gate, head_norm, w_o):
    b, s, _ = xn.shape
    n_chunks = s // GLA_CHUNK
    proj = xn @ w_in
    q, k, v, g, a_low = jnp.split(
        proj, np.cumsum([GLA_DK, GLA_DK, GLA_DV, GLA_DV]).tolist(), axis=-1)
    log_gate = jax.nn.log_sigmoid(
        (a_low @ w_gate_up + b_gate).astype(jnp.float32)) / GLA_GATE_NORMALIZER

    def to_chunks(t, dh):
        t = t.astype(jnp.float32).reshape(b, n_chunks, GLA_CHUNK, GLA_HEADS, dh)
        return t.transpose(1, 0, 3, 2, 4)

    qc = to_chunks(q, GLA_DK_HEAD) * (GLA_DK_HEAD ** -0.5)
    kc = to_chunks(k, GLA_DK_HEAD)
    vc = to_chunks(v, GLA_DV_HEAD)
    gc = to_chunks(log_gate, GLA_DK_HEAD)
    causal = jnp.tril(jnp.ones((GLA_CHUNK, GLA_CHUNK), dtype=bool))

    def step(state, inp):
        qi, ki, vi, gi = inp
        cum = jnp.cumsum(gi, axis=2)
        inter = jnp.einsum('bhcd,bhde->bhce', qi * jnp.exp(cum), state)
        diff = cum[:, :, :, None, :] - cum[:, :, None, :, :]
        decay = jnp.exp(jnp.where(causal[None, None, :, :, None], diff, -jnp.inf))
        scores = jnp.einsum('bhid,bhjd,bhijd->bhij', qi, ki, decay)
        out = inter + jnp.einsum('bhij,bhje->bhie', scores, vi)
        last = cum[:, :, -1:, :]
        new_state = jnp.exp(last)[:, :, 0, :, None] * state + jnp.einsum(
            'bhcd,bhce->bhde', ki * jnp.exp(last - cum), vi)
        return new_state, out

    state0 = jnp.zeros((b, GLA_HEADS, GLA_DK_HEAD, GLA_DV_HEAD), jnp.float32)
    _, o = lax.scan(step, state0, (qc, kc, vc, gc))
    o = o.transpose(1, 0, 3, 2, 4).reshape(b, s, GLA_HEADS, GLA_DV_HEAD)
    o = rms_norm(o, head_norm).reshape(b, s, GLA_DV).astype(xn.dtype)
    return (o * jax.nn.silu(g)) @ w_o


def squared_relu_mlp(xn, w_up, w_down):
    return jnp.square(jax.nn.relu(xn @ w_up)) @ w_down


def setup_inputs(seed: int = 0) -> dict:
    key = jax.random.key(seed)
    ks = jax.random.split(key, 16)
    n_sb = (DEPTH + 2) // 3
    n_conv = (DEPTH + 1) // 3
    n_gla = DEPTH // 3
    f32 = jnp.float32

    def nrm(k, shape, scale):
        return jax.random.normal(k, shape, f32) * scale

    d_in_gla = 2 * GLA_DK + 2 * GLA_DV + GLA_GATE_RANK
    return {
        "x": nrm(ks[0], (BATCH, SEQ, D_MODEL), 1.0),
        "norm_gains": 1.0 + nrm(ks[1], (DEPTH, 4, D_MODEL), 0.02),
        "sb_w_qkv": nrm(ks[2], (n_sb, D_MODEL, 3 * D_MODEL), D_MODEL ** -0.5),
        "sb_w_o": nrm(ks[3], (n_sb, D_MODEL, D_MODEL), D_MODEL ** -0.5),
        "conv_w_in": nrm(ks[4], (n_conv, D_MODEL, 3 * D_MODEL), D_MODEL ** -0.5),
        "conv_w": nrm(ks[5], (n_conv, CONV_WIDTH, D_MODEL), CONV_WIDTH ** -0.5),
        "conv_w_out": nrm(ks[6], (n_conv, D_MODEL, D_MODEL), D_MODEL ** -0.5),
        "gla_w_in": nrm(ks[7], (n_gla, D_MODEL, d_in_gla), D_MODEL ** -0.5),
        "gla_w_gate_up": nrm(ks[8], (n_gla, GLA_GATE_RANK, GLA_DK), GLA_GATE_RANK ** -0.5),
        "gla_b_gate": nrm(ks[9], (n_gla, GLA_DK), 0.1),
        "gla_head_norm": 1.0 + nrm(ks[10], (n_gla, GLA_HEADS, GLA_DV_HEAD), 0.02),
        "gla_w_o": nrm(ks[11], (n_gla, GLA_DV, D_MODEL), GLA_DV ** -0.5),
        "ffn_w_up": nrm(ks[12], (DEPTH, D_MODEL, D_FF), D_MODEL ** -0.5),
        "ffn_w_down": nrm(ks[13], (DEPTH, D_FF, D_MODEL), D_FF ** -0.5),
    }


def reference(x, norm_gains, sb_w_qkv, sb_w_o, conv_w_in, conv_w, conv_w_out,
              gla_w_in, gla_w_gate_up, gla_b_gate, gla_head_norm, gla_w_o,
              ffn_w_up, ffn_w_down):
    h = x
    for i in range(DEPTH):
        kind, j = i % N_MIXERS, i // N_MIXERS
        xn = rms_norm(h, norm_gains[i, 0])
        if kind == 0:
            m = stick_breaking_mixer(xn, sb_w_qkv[j], sb_w_o[j])
        elif kind == 1:
            m = short_conv_mixer(xn, conv_w_in[j], conv_w[j], conv_w_out[j])
        else:
            m = gla_mixer(xn, gla_w_in[j], gla_w_gate_up[j], gla_b_gate[j],
                          gla_head_norm[j], gla_w_o[j])
        h = h + rms_norm(m, norm_gains[i, 1])
        f = squared_relu_mlp(rms_norm(h, norm_gains[i, 2]), ffn_w_up[i], ffn_w_down[i])
        h = h + rms_norm(f, norm_gains[i, 3])
    return h
```

```cpp
#include <hip/hip_runtime.h>
#include <hip/hip_cooperative_groups.h>
#include <cstdio>
#include <cstdint>
namespace cg = cooperative_groups;
namespace pg8 {
#define PG8_LAS __attribute__((address_space(3)))
typedef unsigned short bf16_t;
typedef short bf16x8 __attribute__((ext_vector_type(8)));
typedef float f32x4 __attribute__((ext_vector_type(4)));
typedef unsigned u32x4 __attribute__((ext_vector_type(4)));
constexpr int BM = 256, BK = 64, HALF = 128, HTB = HALF * BK * 2  , STAGE_BYTES = 8 * HTB, NXCD = 8, WGM = 4;

__host__ __device__ __forceinline__ int lds_byte(int r, int c) { const int st = (r >> 4) * 2 + (c >> 5), rr = r & 15, cc = c & 31, ob = rr * 64 + cc * 2; return st * 1024 + (ob ^ (((ob >> 9) & 1) << 5)); }
__host__ __device__ __forceinline__ void stage_rc(int b, int& R, int& C) { const int st = b / 1024, sb = b % 1024, swz = sb ^ (((sb >> 9) & 1) << 5); R = (st >> 1) * 16 + swz / 64; C = (st & 1) * 32 + (swz % 64) / 2; }
__host__ __device__ __forceinline__ int perm32(int rho) { const int n = rho >> 4, i = rho & 15; return 8 * (i >> 2) + 4 * n + (i & 3); }

struct Unit { int pm, pn; };
struct Gemm { const bf16_t* A; const bf16_t* Bt; int M, N, K; };

struct StaticOrder {
    int nM, nN, nwg, G, c;
    __host__ __device__ void init(int M, int N, int G_, int c_) { nM = M / BM; nN = N / BM; nwg = nM * nN; G = G_; c = c_; }
    __host__ __device__ bool next(int i, Unit& u) const {
        const long L = (long)i * G + c; if (L >= nwg) return false;
        int wgid = (int)L; { const int q = nwg / NXCD, r = nwg % NXCD, xcd = wgid % NXCD, off = wgid / NXCD; wgid = (xcd < r ? xcd * (q + 1) : r * (q + 1) + (xcd - r) * q) + off; }
        const int nig = WGM * nN, gid = wgid / nig, fm = gid * WGM, gsz = (nM - fm) < WGM ? (nM - fm) : WGM;
        u.pm = fm + ((wgid % nig) % gsz); u.pn = (wgid % nig) / gsz; return true;
    }
    __device__ __forceinline__ void a_ready(const Unit&) const {}
    __device__ __forceinline__ void done(const Unit&) const {}
};

__device__ __forceinline__ unsigned cvt_pk_bf16(float lo, float hi) { unsigned r; asm volatile("v_cvt_pk_bf16_f32 %0, %1, %2" : "=v"(r) : "v"(lo), "v"(hi)); return r; }
template <int MODE, int SCALE> struct EpiOut {
    static constexpr bool PERM = true, AFTER_DRAIN = false;
    bf16_t* O; int ldc; const float* bias; const float* rs;
    __device__ __forceinline__ void operator()(const f32x4 (&acc)[2][2][4][2], const Unit& u, int wr, int wc, int fr, int fq) const {
        const int row0 = u.pm * BM + wr * 64 + fr; const int col0 = u.pn * BM + wc * 32 + 8 * fq;
        const bool gate = (MODE == 2) && (u.pn >= 12);
        f32x4 bv[2][2], cs[2][2]; float rsv[2][4];
#pragma unroll
        for (int bj = 0; bj < 2; ++bj)
#pragma unroll
            for (int n = 0; n < 2; ++n) { bv[bj][n] = gate ? *(const f32x4*)(bias + (col0 - 3072) + bj * HALF + 4 * n) : (f32x4){0.f, 0.f, 0.f, 0.f};
                if (SCALE == 2) cs[bj][n] = *(const f32x4*)(rs + col0 + bj * HALF + 4 * n); else cs[bj][n] = (f32x4){1.f, 1.f, 1.f, 1.f}; }
#pragma unroll
        for (int ai = 0; ai < 2; ++ai)
#pragma unroll
            for (int m = 0; m < 4; ++m) { if (SCALE == 1) rsv[ai][m] = rs[row0 + ai * HALF + m * 16]; else rsv[ai][m] = 1.f; }
#pragma unroll
        for (int ai = 0; ai < 2; ++ai)
#pragma unroll
            for (int m = 0; m < 4; ++m) { bf16_t* rowp = O + (size_t)(row0 + ai * HALF + m * 16) * ldc + col0;
#pragma unroll
                for (int bj = 0; bj < 2; ++bj) { f32x4 v0 = acc[ai][bj][m][0], v1 = acc[ai][bj][m][1];
                    if (SCALE == 1) { v0 = v0 * rsv[ai][m]; v1 = v1 * rsv[ai][m]; }
                    if (SCALE == 2) { v0 = v0 * cs[bj][0]; v1 = v1 * cs[bj][1]; }
                    if (MODE == 1) {
#pragma unroll
                        for (int j = 0; j < 4; ++j) { const float a = fmaxf(v0[j], 0.f), b = fmaxf(v1[j], 0.f); v0[j] = a * a; v1[j] = b * b; } }
                    if (MODE == 2) { if (gate) { v0 = v0 + bv[bj][0]; v1 = v1 + bv[bj][1];
#pragma unroll
                        for (int j = 0; j < 4; ++j) { const float a = v0[j], b = v1[j];
                            v0[j] = (fminf(a, 0.f) - __logf(1.f + __expf(-fabsf(a)))) * 0.0625f; v1[j] = (fminf(b, 0.f) - __logf(1.f + __expf(-fabsf(b)))) * 0.0625f; } } }
                    u32x4 w; w.x = cvt_pk_bf16(v0[0], v0[1]); w.y = cvt_pk_bf16(v0[2], v0[3]); w.z = cvt_pk_bf16(v1[0], v1[1]); w.w = cvt_pk_bf16(v1[2], v1[3]);
                    *(u32x4*)(rowp + bj * HALF) = w; } }
    }
};

template <class Epi, class Sched, bool ALIGN_EPI = false, bool SP2 = false>
__device__ __forceinline__ void gemm_phase(PG8_LAS unsigned char* lds, const Gemm g, const Sched& S, const Epi& E) {
    int tid = threadIdx.x; asm volatile("" : "+v"(tid));
    const int wid = __builtin_amdgcn_readfirstlane(tid >> 6), lane = tid & 63, wr = wid >> 2, wc = wid & 3, fr = lane & 15, fq = lane >> 4;
    const int K = g.K, nt = K / BK;
    unsigned voffA[2], voffB[2];
#pragma unroll
    for (int i = 0; i < 2; ++i) { int R, C; stage_rc(tid * 16 + i * 8192, R, C); const int Rb = Epi::PERM ? ((R & ~31) + perm32(R & 31)) : R;
        voffA[i] = (unsigned)(R * K + C) * 2u; voffB[i] = (unsigned)(Rb * K + C) * 2u; }
    const size_t kstep = (size_t)(BK * 2);
    const size_t hstep = (size_t)HALF * K * 2;
    const size_t tstep = 2 * hstep;
    const unsigned ldsw = (unsigned)wid * 1024u;
    const int aoff = lds_byte(wr * 64 + fr, fq * 8), boff = lds_byte(wc * 32 + fr, fq * 8);
#define PG8_SA(b, h) (((b) * 2 + (h)) * HTB)
#define PG8_SB(b, h) ((4 + (b) * 2 + (h)) * HTB)
#define PG8_STAGE(bufoff, gbase, voff) do { _Pragma("unroll") for (int _i = 0; _i < 2; ++_i) \
        __builtin_amdgcn_global_load_lds((const unsigned*)((const char*)(gbase) + (voff)[_i]), (PG8_LAS unsigned*)(lds + (bufoff) + ldsw + _i * 8192), 16, 0, 0); } while (0)
#define PG8_LDA(dst, b, h) do { _Pragma("unroll") for (int m = 0; m < 4; ++m) _Pragma("unroll") for (int k = 0; k < 2; ++k) dst[m][k] = *(const PG8_LAS bf16x8*)(lds + PG8_SA(b, h) + aoff + m * 2048 + k * 1024); } while (0)
#define PG8_LDB(dst, b, h) do { _Pragma("unroll") for (int n = 0; n < 2; ++n) _Pragma("unroll") for (int k = 0; k < 2; ++k) dst[n][k] = *(const PG8_LAS bf16x8*)(lds + PG8_SB(b, h) + boff + n * 2048 + k * 1024); } while (0)
#define PG8_MMA(ai, bj, At, Bt) do { __builtin_amdgcn_s_setprio(1); _Pragma("unroll") for (int m = 0; m < 4; ++m) _Pragma("unroll") for (int n = 0; n < 2; ++n) _Pragma("unroll") for (int k = 0; k < 2; ++k) \
        acc[ai][bj][m][n] = __builtin_amdgcn_mfma_f32_16x16x32_bf16(Bt[n][k], At[m][k], acc[ai][bj][m][n], 0, 0, 0); __builtin_amdgcn_s_setprio(0); } while (0)
#define PG8_WAIT_V(n) asm volatile("s_waitcnt vmcnt(" #n ")" ::: "memory")
#define PG8_WAIT_L(n) asm volatile("s_waitcnt lgkmcnt(" #n ")" ::: "memory")
#define PG8_BAR __builtin_amdgcn_s_barrier()
#define PG8_SCHED __builtin_amdgcn_sched_barrier(0)
    Unit cur, nxt; int ui = 0;
    if (!S.next(0, cur)) return;
    f32x4 acc[2][2][4][2];
#pragma unroll
    for (int a = 0; a < 2; ++a)
#pragma unroll
        for (int b = 0; b < 2; ++b)
#pragma unroll
            for (int m = 0; m < 4; ++m)
#pragma unroll
                for (int n = 0; n < 2; ++n) acc[a][b][m][n] = (f32x4){0.f, 0.f, 0.f, 0.f};
    bf16x8 At[4][2], B0[2][2], B1[2][2];
    const char* cA = (const char*)g.A + (size_t)cur.pm * tstep; const char* cB = (const char*)g.Bt + (size_t)cur.pn * tstep;
    S.a_ready(cur);
    if constexpr (SP2) {
        PG8_STAGE(PG8_SB(0, 0), cB, voffB); PG8_STAGE(PG8_SB(0, 1), cB + hstep, voffB); PG8_STAGE(PG8_SA(0, 0), cA, voffA); PG8_STAGE(PG8_SA(0, 1), cA + hstep, voffA);
        if (wr == 1) PG8_BAR;
        PG8_WAIT_V(2); PG8_BAR;
        PG8_STAGE(PG8_SB(1, 0), cB + kstep, voffB); PG8_STAGE(PG8_SA(1, 0), cA + kstep, voffA); PG8_STAGE(PG8_SB(1, 1), cB + hstep + kstep, voffB);
        PG8_WAIT_V(6); PG8_BAR;
    } else {
        PG8_STAGE(PG8_SB(0, 0), cB, voffB); PG8_STAGE(PG8_SA(0, 0), cA, voffA); PG8_STAGE(PG8_SB(0, 1), cB + hstep, voffB); PG8_STAGE(PG8_SA(0, 1), cA + hstep, voffA);
        if (wr == 1) PG8_BAR;
        PG8_WAIT_V(4); PG8_BAR;
        PG8_STAGE(PG8_SB(1, 0), cB + kstep, voffB); PG8_STAGE(PG8_SA(1, 0), cA + kstep, voffA); PG8_STAGE(PG8_SB(1, 1), cB + hstep + kstep, voffB);
        PG8_WAIT_V(6); PG8_BAR;
    }
    for (;;) {
        const bool has_next = S.next(ui + 1, nxt);
        const char* nA = has_next ? (const char*)g.A + (size_t)nxt.pm * tstep : cA; const char* nB = has_next ? (const char*)g.Bt + (size_t)nxt.pn * tstep : cB;
        for (int t = 0; t < nt; t += 2) {
            const bool last = (t == nt - 2);
            const char* a1 = cA + (size_t)(t + 1) * kstep;
            const char* a2 = last ? nA : cA + (size_t)(t + 2) * kstep; const char* b2 = last ? nB : cB + (size_t)(t + 2) * kstep;
            const char* a3 = a2 + kstep; const char* b3 = b2 + kstep;
            if (last && has_next) S.a_ready(nxt);
            if constexpr (SP2) {
            PG8_LDB(B0, 0, 0); PG8_LDB(B1, 0, 1); PG8_SCHED; PG8_LDA(At, 0, 0); PG8_STAGE(PG8_SA(1, 1), a1 + hstep, voffA);
            PG8_WAIT_V(8); PG8_WAIT_L(0); PG8_BAR; PG8_MMA(0, 0, At, B0); PG8_MMA(0, 1, At, B1); PG8_BAR; PG8_SCHED;
            PG8_LDA(At, 0, 1); PG8_STAGE(PG8_SB(0, 0), b2, voffB); PG8_STAGE(PG8_SB(0, 1), b2 + hstep, voffB); PG8_STAGE(PG8_SA(0, 0), a2, voffA);
            PG8_WAIT_V(8); PG8_WAIT_L(0); PG8_BAR; PG8_MMA(1, 0, At, B0); PG8_MMA(1, 1, At, B1); PG8_BAR; PG8_SCHED;
            PG8_LDB(B0, 1, 0); PG8_LDB(B1, 1, 1); PG8_SCHED; PG8_LDA(At, 1, 0); PG8_STAGE(PG8_SA(0, 1), a2 + hstep, voffA);
            PG8_WAIT_V(8); PG8_WAIT_L(0); PG8_BAR; PG8_MMA(0, 0, At, B0); PG8_MMA(0, 1, At, B1); PG8_BAR; PG8_SCHED;
            PG8_LDA(At, 1, 1); PG8_STAGE(PG8_SB(1, 0), b3, voffB); PG8_STAGE(PG8_SB(1, 1), b3 + hstep, voffB); PG8_STAGE(PG8_SA(1, 0), a3, voffA);
            PG8_WAIT_V(8); PG8_WAIT_L(0); PG8_BAR; PG8_MMA(1, 0, At, B0); PG8_MMA(1, 1, At, B1); PG8_BAR; PG8_SCHED;
            } else {
            PG8_LDB(B0, 0, 0); PG8_SCHED; PG8_LDA(At, 0, 0); PG8_STAGE(PG8_SA(1, 1), a1 + hstep, voffA);
            PG8_WAIT_L(8); PG8_BAR; PG8_WAIT_L(0); PG8_MMA(0, 0, At, B0); PG8_BAR; PG8_SCHED;
            PG8_LDB(B1, 0, 1); PG8_STAGE(PG8_SB(0, 0), b2, voffB);
            PG8_BAR; PG8_WAIT_L(0); PG8_MMA(0, 1, At, B1); PG8_BAR;
            PG8_LDA(At, 0, 1); PG8_STAGE(PG8_SA(0, 0), a2, voffA);
            PG8_BAR; PG8_WAIT_L(0); PG8_MMA(1, 0, At, B0); PG8_BAR; PG8_SCHED;
            PG8_STAGE(PG8_SB(0, 1), b2 + hstep, voffB);
            PG8_WAIT_V(6); PG8_BAR; PG8_MMA(1, 1, At, B1); PG8_BAR;
            PG8_LDB(B0, 1, 0); PG8_SCHED; PG8_LDA(At, 1, 0); PG8_STAGE(PG8_SA(0, 1), a2 + hstep, voffA);
            PG8_WAIT_L(8); PG8_BAR; PG8_WAIT_L(0); PG8_MMA(0, 0, At, B0); PG8_BAR; PG8_SCHED;
            PG8_LDB(B1, 1, 1); PG8_STAGE(PG8_SB(1, 0), b3, voffB);
            PG8_BAR; PG8_WAIT_L(0); PG8_MMA(0, 1, At, B1); PG8_BAR;
            PG8_LDA(At, 1, 1); PG8_STAGE(PG8_SA(1, 0), a3, voffA);
            PG8_BAR; PG8_WAIT_L(0); PG8_MMA(1, 0, At, B0); PG8_BAR; PG8_SCHED;
            PG8_STAGE(PG8_SB(1, 1), b3 + hstep, voffB);
            PG8_WAIT_V(6); PG8_BAR; PG8_MMA(1, 1, At, B1); PG8_BAR;
            }
        }
        if constexpr (ALIGN_EPI) { if (wr == 0) PG8_BAR; }
        if constexpr (!Epi::AFTER_DRAIN) { E(acc, cur, wr, wc, fr, fq); S.done(cur); }
        if (!has_next) break;
#pragma unroll
        for (int a = 0; a < 2; ++a)
#pragma unroll
            for (int b = 0; b < 2; ++b)
#pragma unroll
                for (int m = 0; m < 4; ++m)
#pragma unroll
                    for (int n = 0; n < 2; ++n) acc[a][b][m][n] = (f32x4){0.f, 0.f, 0.f, 0.f};
        cur = nxt; cA = nA; cB = nB; ++ui;
        if constexpr (ALIGN_EPI) { if (wr == 1) PG8_BAR; }
    }
    PG8_WAIT_V(0);
    if constexpr (!ALIGN_EPI) { if (wr == 0) PG8_BAR; }
    PG8_BAR;
    if constexpr (Epi::AFTER_DRAIN) { E.fused(acc, cur, wr, wc, fr, fq, lds, wid, lane); S.done(cur); }
#undef PG8_SA
#undef PG8_SB
#undef PG8_STAGE
#undef PG8_LDA
#undef PG8_LDB
#undef PG8_MMA
#undef PG8_WAIT_V
#undef PG8_WAIT_L
#undef PG8_BAR
#undef PG8_SCHED
}
}

#define LAS __attribute__((address_space(3)))
typedef unsigned short bf16;
typedef unsigned v4u __attribute__((ext_vector_type(4)));
typedef unsigned v2u __attribute__((ext_vector_type(2)));
typedef float f32x4 __attribute__((ext_vector_type(4)));
typedef float f32x16 __attribute__((ext_vector_type(16)));
typedef short bf16x8 __attribute__((ext_vector_type(8)));
typedef short bf16x4 __attribute__((ext_vector_type(4)));

#ifndef REP_ATTN
#define REP_ATTN 1
#endif
#ifndef REP_GLA
#define REP_GLA 1
#endif
#ifndef REP_GEMM
#define REP_GEMM 1
#endif
#ifndef REP_CONV
#define REP_CONV 1
#endif
#ifndef MK_COOP
#define MK_COOP 1
#endif

constexpr int NB = 8, SEQ = 4096, T = NB * SEQ, D = 1024, FF = 4096, DEPTH = 4;
constexpr float EPS = 1e-6f;
constexpr int NWAVES = 8, NTHR = 512;
constexpr int LDS_BYTES = 131072 + 2048;
constexpr int NSTEPS = 1 + 9 * DEPTH;

constexpr size_t MiB = (size_t)1 << 20;
constexpr size_t WS_BAR = 0;
constexpr size_t WS_RH = 512 * 1024;
constexpr size_t WS_PART = 1 * MiB;
constexpr size_t WS_W = 10 * MiB;
constexpr size_t W_QKV = 0;
constexpr size_t W_SBO = W_QKV + (size_t)2 * 3072 * 1024;
constexpr size_t W_CIN = W_SBO + (size_t)2 * 1024 * 1024;
constexpr size_t W_COUT = W_CIN + (size_t)3072 * 1024;
constexpr size_t W_GIN = W_COUT + (size_t)1024 * 1024;
constexpr size_t W_GO = W_GIN + (size_t)3584 * 1024;
constexpr size_t W_UP = W_GO + (size_t)1024 * 1024;
constexpr size_t W_DN = W_UP + (size_t)4 * 4096 * 1024;
constexpr size_t W_END = W_DN + (size_t)4 * 4096 * 1024;
constexpr size_t WS_XN = 108 * MiB;
constexpr size_t WS_M = 172 * MiB;
constexpr size_t WS_BIG = 236 * MiB;
constexpr size_t WS_END = 492 * MiB;
static_assert(WS_W + W_END * 2 <= WS_XN, "weights fit");

#define LDS_WAIT() asm volatile("s_waitcnt lgkmcnt(0)" ::: "memory")
#define LBAR() do { asm volatile("s_waitcnt lgkmcnt(0)" ::: "memory"); __builtin_amdgcn_s_barrier(); asm volatile("" ::: "memory"); } while (0)
__device__ __forceinline__ unsigned f2bf(float f) { unsigned u = __builtin_bit_cast(unsigned, f); return (u + 0x7fffu + ((u >> 16) & 1u)) >> 16; }
__device__ __forceinline__ unsigned pk2(float lo, float hi) { return pg8::cvt_pk_bf16(lo, hi); }
__device__ __forceinline__ float bf2f(unsigned short b) { return __builtin_bit_cast(float, ((unsigned)b) << 16); }
__device__ __forceinline__ float bflo(unsigned w) { return __builtin_bit_cast(float, w << 16); }
__device__ __forceinline__ float bfhi(unsigned w) { return __builtin_bit_cast(float, w & 0xffff0000u); }
__device__ __forceinline__ float wave_sum(float v) {
#pragma unroll
    for (int o = 1; o < 64; o <<= 1) v += __shfl_xor(v, o);
    return v;
}

#define XB_TMO      128
#define XB_XCNT(j)  (256  + 64 * (j))
#define XB_XSUB(j)  (1280 + 64 * (j))
#define XB_XGEN(j)  (2304 + 64 * (j))
#define XB_TOP      3328
#define XB_TOPGEN   3392
#define XCD_BAR_WORDS 3456
#define XB_SPIN_CAP (1u << 18)

__device__ __forceinline__ unsigned xb_ld(unsigned* p)              { return __hip_atomic_load(p, __ATOMIC_RELAXED, __HIP_MEMORY_SCOPE_AGENT); }
__device__ __forceinline__ unsigned xb_add(unsigned* p, unsigned v) { return __hip_atomic_fetch_add(p, v, __ATOMIC_RELAXED, __HIP_MEMORY_SCOPE_AGENT); }
__device__ __forceinline__ unsigned xb_xcc_id() { return (unsigned)__builtin_amdgcn_s_getreg((3 << 11) | 20) & 0xFu; }
#define XB_SPIN(cond, bar) do { unsigned _sp = 0; while (cond) { __builtin_amdgcn_s_sleep(1); \
    if ((++_sp & 255u) == 0u) { if (xb_ld(&(bar)[XB_TMO])) break; if (_sp > XB_SPIN_CAP) { atomicAdd(&(bar)[XB_TMO], 1u); break; } } } } while (0)

struct XcdBarrier {
    unsigned* bar; unsigned x;
    volatile LAS unsigned* st;
};

__device__ __forceinline__ XcdBarrier xcd_barrier_post(unsigned* bar, volatile LAS unsigned* st) {
    XcdBarrier b; b.bar = bar; b.x = xb_xcc_id(); b.st = st;
    if (threadIdx.x == 0) (void)xb_add(&bar[XB_XCNT(b.x)], 1u);
    return b;
}
__device__ __forceinline__ void xcd_barrier_complete(unsigned* bar, unsigned x, unsigned& nloc, unsigned& nx) {
    const unsigned G = gridDim.x * gridDim.y * gridDim.z;
    unsigned sum, cnt, mine, sp = 0u;
    for (;;) {
        sum = 0u; cnt = 0u; mine = 0u;
#pragma unroll
        for (unsigned j = 0; j < 16; ++j) { const unsigned c = xb_ld(&bar[XB_XCNT(j)]); sum += c; cnt += (c > 0u) ? 1u : 0u; mine = (j == x) ? c : mine; }
        if (sum == G) break;
        __builtin_amdgcn_s_sleep(1);
        if ((++sp & 255u) == 0u) { if (xb_ld(&bar[XB_TMO])) break; if (sp > XB_SPIN_CAP) { atomicAdd(&bar[XB_TMO], 1u); break; } }
    }
    nloc = mine > 0u ? mine : 1u; nx = cnt > 0u ? cnt : 1u;
}

__device__ __forceinline__ void xcd_barrier(const XcdBarrier& b) {
    asm volatile("s_waitcnt vmcnt(0)" ::: "memory");
    __syncthreads();
    if (threadIdx.x == 0) {
        unsigned* bar = b.bar;
        __builtin_amdgcn_s_waitcnt(0);
        unsigned nloc = b.st[0], nx = b.st[1];
        if (nloc == 0u) { xcd_barrier_complete(bar, b.x, nloc, nx); b.st[0] = nloc; b.st[1] = nx; }
        const unsigned old = xb_add(&bar[XB_XSUB(b.x)], 1u);
        const unsigned gen = old / nloc;
        if (old + 1u == (gen + 1u) * nloc) {
            __builtin_amdgcn_fence(__ATOMIC_RELEASE, "agent");
            asm volatile("s_waitcnt vmcnt(0)" ::: "memory");
            const unsigned og = xb_add(&bar[XB_TOP], 1u);
            const unsigned tg = og / nx;
            if (og + 1u == (tg + 1u) * nx) xb_add(&bar[XB_TOPGEN], 1u);
            else XB_SPIN(xb_ld(&bar[XB_TOPGEN]) == tg, bar);
            __builtin_amdgcn_fence(__ATOMIC_ACQUIRE, "agent");
            xb_add(&bar[XB_XGEN(b.x)], 1u);
            asm volatile("s_waitcnt vmcnt(0)" ::: "memory");
        } else {
            XB_SPIN(xb_ld(&bar[XB_XGEN(b.x)]) == gen, bar);
            __builtin_amdgcn_fence(__ATOMIC_ACQUIRE, "agent");
            asm volatile("s_waitcnt vmcnt(0)" ::: "memory");
        }
    }
    __syncthreads();
}

__device__ __forceinline__ void transpose_item(const float* W, int ldw, int K, int nblk, bf16* WT, LAS float* scr, int item, int lane, const float* gk, int nscale) {
    const int kb = item / nblk, nb = item % nblk, k0 = 64 * kb, n0 = 32 * nb;
    float tv[32];
#pragma unroll
    for (int i = 0; i < 32; ++i) { const int kk = 2 * i + (lane >> 5); tv[i] = W[(size_t)(k0 + kk) * ldw + n0 + (lane & 31)]; }
    if (gk) {
#pragma unroll
        for (int i = 0; i < 32; ++i) { const int kk = 2 * i + (lane >> 5); tv[i] *= gk[k0 + kk]; } }
    if (n0 < nscale) {
#pragma unroll
        for (int i = 0; i < 32; ++i) tv[i] *= 0.18033688011112042f; }
#pragma unroll
    for (int i = 0; i < 32; ++i) { const int kk = 2 * i + (lane >> 5); scr[kk * 33 + (lane & 31)] = tv[i]; }
    LDS_WAIT();
    const int c = lane & 7;
#pragma unroll
    for (int j = 0; j < 4; ++j) { const int n = (lane >> 3) + 8 * j; const LAS float* s = scr + (8 * c) * 33 + n;
        v4u o; o.x = pk2(s[0 * 33], s[1 * 33]); o.y = pk2(s[2 * 33], s[3 * 33]); o.z = pk2(s[4 * 33], s[5 * 33]); o.w = pk2(s[6 * 33], s[7 * 33]);
        *(v4u*)(WT + (size_t)(n0 + n) * K + k0 + 8 * c) = o; }
    LDS_WAIT();
}

template <bool HIN_F32, bool HAS_M, bool FINAL>
__device__ __forceinline__ void resid_pass(const float* hin32, const bf16* m, const float* g_post, bf16* hb, float* out32, float* rh, int gw, int NGW, int lane) {
    for (int row0 = gw; row0 < T; row0 += 2 * NGW) {
        const int row1 = row0 + NGW; const bool two = row1 < T; const int r1 = two ? row1 : row0;
        f32x4 v0[4], v1[4];
        if (HIN_F32) { const f32x4* hp0 = (const f32x4*)(hin32 + (size_t)row0 * D) + lane; const f32x4* hp1 = (const f32x4*)(hin32 + (size_t)r1 * D) + lane;
#pragma unroll
            for (int j = 0; j < 4; ++j) { v0[j] = hp0[64 * j]; v1[j] = hp1[64 * j]; } }
        else { const v2u* hp0 = (const v2u*)(hb + (size_t)row0 * D) + lane; const v2u* hp1 = (const v2u*)(hb + (size_t)r1 * D) + lane; v2u a[4], b[4];
#pragma unroll
            for (int j = 0; j < 4; ++j) { a[j] = hp0[64 * j]; b[j] = hp1[64 * j]; }
#pragma unroll
            for (int j = 0; j < 4; ++j) { v0[j] = (f32x4){bflo(a[j].x), bfhi(a[j].x), bflo(a[j].y), bfhi(a[j].y)}; v1[j] = (f32x4){bflo(b[j].x), bfhi(b[j].x), bflo(b[j].y), bfhi(b[j].y)}; } }
        if (HAS_M) {
            const v2u* mp0 = (const v2u*)(m + (size_t)row0 * D) + lane; const v2u* mp1 = (const v2u*)(m + (size_t)r1 * D) + lane;
            v2u w0[4], w1[4];
#pragma unroll
            for (int j = 0; j < 4; ++j) { w0[j] = mp0[64 * j]; w1[j] = mp1[64 * j]; }
            f32x4 gp[4];
#pragma unroll
            for (int j = 0; j < 4; ++j) gp[j] = ((const f32x4*)g_post)[lane + 64 * j];
            f32x4 a0[4], a1[4]; float s0 = 0.f, s1 = 0.f;
#pragma unroll
            for (int j = 0; j < 4; ++j) { a0[j] = (f32x4){bflo(w0[j].x), bfhi(w0[j].x), bflo(w0[j].y), bfhi(w0[j].y)}; a1[j] = (f32x4){bflo(w1[j].x), bfhi(w1[j].x), bflo(w1[j].y), bfhi(w1[j].y)};
                s0 += (a0[j].x * a0[j].x + a0[j].y * a0[j].y) + (a0[j].z * a0[j].z + a0[j].w * a0[j].w); s1 += (a1[j].x * a1[j].x + a1[j].y * a1[j].y) + (a1[j].z * a1[j].z + a1[j].w * a1[j].w); }
#pragma unroll
            for (int o = 1; o < 64; o <<= 1) { s0 += __shfl_xor(s0, o); s1 += __shfl_xor(s1, o); }
            const float rm0 = 1.0f / sqrtf(s0 * (1.f / D) + EPS), rm1 = 1.0f / sqrtf(s1 * (1.f / D) + EPS);
#pragma unroll
            for (int j = 0; j < 4; ++j) { v0[j] = v0[j] + a0[j] * rm0 * gp[j]; v1[j] = v1[j] + a1[j] * rm1 * gp[j]; }
        }
        if (FINAL) {
            f32x4* op0 = (f32x4*)(out32 + (size_t)row0 * D) + lane; f32x4* op1 = (f32x4*)(out32 + (size_t)r1 * D) + lane;
#pragma unroll
            for (int j = 0; j < 4; ++j) { op0[64 * j] = v0[j]; if (two) op1[64 * j] = v1[j]; }
        } else {
            float s0 = 0.f, s1 = 0.f;
#pragma unroll
            for (int j = 0; j < 4; ++j) { s0 += (v0[j].x * v0[j].x + v0[j].y * v0[j].y) + (v0[j].z * v0[j].z + v0[j].w * v0[j].w); s1 += (v1[j].x * v1[j].x + v1[j].y * v1[j].y) + (v1[j].z * v1[j].z + v1[j].w * v1[j].w); }
#pragma unroll
            for (int o = 1; o < 64; o <<= 1) { s0 += __shfl_xor(s0, o); s1 += __shfl_xor(s1, o); }
            if (lane == 0) { rh[row0] = 1.0f / sqrtf(s0 * (1.f / D) + EPS); if (two) rh[row1] = 1.0f / sqrtf(s1 * (1.f / D) + EPS); }
            v2u* xp0 = (v2u*)(hb + (size_t)row0 * D) + lane; v2u* xp1 = (v2u*)(hb + (size_t)r1 * D) + lane;
#pragma unroll
            for (int j = 0; j < 4; ++j) { v2u w; w.x = pk2(v0[j].x, v0[j].y); w.y = pk2(v0[j].z, v0[j].w); xp0[64 * j] = w;
                if (two) { v2u u; u.x = pk2(v1[j].x, v1[j].y); u.y = pk2(v1[j].z, v1[j].w); xp1[64 * j] = u; } }
        }
    }
}

#define CAT4(lo, hi) ((bf16x8){lo[0], lo[1], lo[2], lo[3], hi[0], hi[1], hi[2], hi[3]})
struct SbRaw { v4u k[4]; v4u v[4]; };
template <bool DIAG> __device__ __forceinline__ void sb_tile(const f32x16& st, const int hb, const int qrel, float& C, bf16x8& pa0, bf16x8& pa1) {
    float r[16], be[16];
#pragma unroll
    for (int i = 0; i < 16; ++i) { const float e = __builtin_amdgcn_exp2f(st[i]); const float rr = __builtin_amdgcn_rcpf(1.f + e);
        if (DIAG) { const int kap = 8 * (i >> 2) + 4 * hb + (i & 3); const bool vis = kap < qrel; r[i] = vis ? rr : 1.f; be[i] = vis ? 1.f - rr : 0.f; }
        else { r[i] = rr; be[i] = 1.f - rr; } }
    float pg[4], og[4];
#pragma unroll
    for (int g = 0; g < 4; ++g) pg[g] = (r[4 * g] * r[4 * g + 1]) * (r[4 * g + 2] * r[4 * g + 3]);
#pragma unroll
    for (int g = 0; g < 4; ++g) {
        const unsigned xb = __builtin_bit_cast(unsigned, pg[g]); const auto r = __builtin_amdgcn_permlane32_swap(xb, xb, false, false);
        og[g] = __builtin_bit_cast(float, hb ? (unsigned)r[0] : (unsigned)r[1]); }
    float E[4]; float run = C;
#pragma unroll
    for (int g = 3; g >= 0; --g) { E[g] = (hb == 0) ? run * og[g] : run; run *= pg[g] * og[g]; }
    C = run;
    float wv[16];
#pragma unroll
    for (int g = 0; g < 4; ++g) { float S = E[g];
#pragma unroll
        for (int q = 3; q >= 0; --q) { const int i = 4 * g + q; wv[i] = be[i] * S; S *= r[i]; } }
    v4u t0; t0.x = pk2(wv[0], wv[1]); t0.y = pk2(wv[2], wv[3]); t0.z = pk2(wv[4], wv[5]); t0.w = pk2(wv[6], wv[7]); pa0 = __builtin_bit_cast(bf16x8, t0);
    v4u t1; t1.x = pk2(wv[8], wv[9]); t1.y = pk2(wv[10], wv[11]); t1.z = pk2(wv[12], wv[13]); t1.w = pk2(wv[14], wv[15]); pa1 = __builtin_bit_cast(bf16x8, t1);
}
__device__ __forceinline__ void sb_attn_phase(LAS unsigned char* lds, int wave, const bf16* QK, const bf16* VTg, bf16* O, int gw, int NGW, int lane) {
    const int n = lane & 31, hb = lane >> 5;
    LAS bf16* Kb = (LAS bf16*)(lds + wave * 10240);
    LAS bf16* Vb = Kb + 32 * 72;
    for (int u0 = gw; u0 < NB * 16 * 128; u0 += NGW) {
        int u = u0;
        if (NGW == 2048) { const int blk = u0 >> 3 & 255, wv = u0 & 7, rnd = u0 >> 11; u = ((blk & 7) << 11) | (rnd << 8) | ((blk >> 3) << 3) | wv; }
        const int qb = u & 127, bh = u >> 7, h = bh & 15, b = bh >> 4;
        const int q0 = qb * 32; const size_t tok0 = (size_t)b * SEQ;
        bf16x8 qf[4];
        {
            const bf16* qg = QK + (tok0 + q0 + (lane >> 3)) * 2048 + h * 64 + 8 * (lane & 7);
            v4u qv[4];
#pragma unroll
            for (int i = 0; i < 4; ++i) qv[i] = *(const v4u*)(qg + (size_t)(8 * i) * 2048);
#pragma unroll
            for (int i = 0; i < 4; ++i) *(LAS v4u*)(Kb + (8 * i + (lane >> 3)) * 72 + 8 * (lane & 7)) = qv[i];
#pragma unroll
            for (int s = 0; s < 4; ++s) qf[s] = *(const LAS bf16x8*)(Kb + n * 72 + 16 * s + 8 * hb);
        }
        f32x16 o0, o1;
#pragma unroll
        for (int i = 0; i < 16; ++i) { o0[i] = 0.f; o1[i] = 0.f; }
        float C = 1.f;
        const int kr = lane >> 3, kc = lane & 7, vr = lane >> 2, vc = lane & 3;
        const bf16* kg = QK + (tok0 + kr) * 2048 + 1024 + h * 64 + 8 * kc;
        const bf16* vg = VTg + (size_t)(h * 64 + vr) * T + tok0 + 8 * vc;
        SbRaw ks[2];
#define SB_LOAD(S, k0_) do { \
            _Pragma("unroll") for (int i = 0; i < 4; ++i) { S.k[i] = *(const v4u*)(kg + (size_t)((k0_) + 8 * i) * 2048); S.v[i] = *(const v4u*)(vg + (size_t)(16 * i) * T + (k0_)); } } while (0)
        SB_LOAD(ks[0], q0);
        if (qb >= 1) SB_LOAD(ks[1], q0 - 32);
        int kt = qb; bool done = false;
        while (!done) {
#pragma unroll
            for (int j = 0; j < 2; ++j) {
#pragma unroll
                for (int i = 0; i < 4; ++i) { *(LAS v4u*)(Kb + (8 * i + kr) * 72 + 8 * kc) = ks[j].k[i]; *(LAS v4u*)(Vb + (16 * i + vr) * 40 + 8 * vc) = ks[j].v[i]; }
                if (kt >= 2) SB_LOAD(ks[j], (kt - 2) * 32);
                bf16x8 kf[4]; bf16x4 va[2][4];
#pragma unroll
                for (int s = 0; s < 4; ++s) kf[s] = *(const LAS bf16x8*)(Kb + n * 72 + 16 * s + 8 * hb);
#pragma unroll
                for (int p = 0; p < 4; ++p) { va[0][p] = *(const LAS bf16x4*)(Vb + n * 40 + 8 * p + 4 * hb); va[1][p] = *(const LAS bf16x4*)(Vb + (32 + n) * 40 + 8 * p + 4 * hb); }
                f32x16 st;
#pragma unroll
                for (int i = 0; i < 16; ++i) st[i] = 0.f;
#pragma unroll
                for (int s = 0; s < 4; ++s) st = __builtin_amdgcn_mfma_f32_32x32x16_bf16(kf[s], qf[s], st, 0, 0, 0);
                bf16x8 pa0, pa1;
                if (kt == qb) sb_tile<true>(st, hb, n, C, pa0, pa1);
                else sb_tile<false>(st, hb, 0, C, pa0, pa1);
                o0 = __builtin_amdgcn_mfma_f32_32x32x16_bf16(pa0, CAT4(va[0][0], va[0][1]), o0, 0, 0, 0);
                o0 = __builtin_amdgcn_mfma_f32_32x32x16_bf16(pa1, CAT4(va[0][2], va[0][3]), o0, 0, 0, 0);
                o1 = __builtin_amdgcn_mfma_f32_32x32x16_bf16(pa0, CAT4(va[1][0], va[1][1]), o1, 0, 0, 0);
                o1 = __builtin_amdgcn_mfma_f32_32x32x16_bf16(pa1, CAT4(va[1][2], va[1][3]), o1, 0, 0, 0);
                if (kt == 0 || __all(C < 1.17549435e-38f)) { done = true; break; }
                --kt;
            }
        }
#undef SB_LOAD
        {
#pragma unroll
            for (int i = 0; i < 16; ++i) { const int row = 8 * (i >> 2) + 4 * hb + (i & 3); Kb[row * 72 + n] = (bf16)f2bf(o0[i]); Kb[row * 72 + 32 + n] = (bf16)f2bf(o1[i]); }
            bf16* og = O + (tok0 + q0 + (lane >> 3)) * D + h * 64 + 8 * (lane & 7);
#pragma unroll
            for (int i = 0; i < 4; ++i) { const v4u w = *(const LAS v4u*)(Kb + (8 * i + (lane >> 3)) * 72 + 8 * (lane & 7)); *(v4u*)(og + (size_t)(8 * i) * D) = w; }
        }
    }
}

__device__ __forceinline__ void conv_phase(const bf16* BIG, const float* cw, bf16* O, int gtid, int NT) {
    for (int it = gtid; it < (T / 8) * 128; it += NT) {
        const int cgp = it & 127, tb = it >> 7, t0 = tb * 8, c0 = cgp * 8;
        float w0[8], w1[8], w2[8], hm2[8], hm1[8];
#pragma unroll
        for (int e = 0; e < 8; ++e) { w0[e] = cw[c0 + e]; w1[e] = cw[D + c0 + e]; w2[e] = cw[2 * D + c0 + e]; hm2[e] = 0.f; hm1[e] = 0.f; }
        if ((t0 & (SEQ - 1)) != 0) {
#pragma unroll
            for (int p = 0; p < 2; ++p) { const bf16* rp = BIG + (size_t)(t0 - 2 + p) * 3072 + c0; const v4u cv = *(const v4u*)(rp + 1024), uv = *(const v4u*)(rp + 2048);
                float hc[8] = {bflo(cv.x) * bflo(uv.x), bfhi(cv.x) * bfhi(uv.x), bflo(cv.y) * bflo(uv.y), bfhi(cv.y) * bfhi(uv.y), bflo(cv.z) * bflo(uv.z), bfhi(cv.z) * bfhi(uv.z), bflo(cv.w) * bflo(uv.w), bfhi(cv.w) * bfhi(uv.w)};
#pragma unroll
                for (int e = 0; e < 8; ++e) { if (p == 0) hm2[e] = hc[e]; else hm1[e] = hc[e]; } }
        }
#pragma unroll
        for (int i = 0; i < 8; ++i) { const bf16* rp = BIG + (size_t)(t0 + i) * 3072 + c0; const v4u bv = *(const v4u*)rp, cv = *(const v4u*)(rp + 1024), uv = *(const v4u*)(rp + 2048);
            float hc[8] = {bflo(cv.x) * bflo(uv.x), bfhi(cv.x) * bfhi(uv.x), bflo(cv.y) * bflo(uv.y), bfhi(cv.y) * bfhi(uv.y), bflo(cv.z) * bflo(uv.z), bfhi(cv.z) * bfhi(uv.z), bflo(cv.w) * bflo(uv.w), bfhi(cv.w) * bfhi(uv.w)};
            float bb[8] = {bflo(bv.x), bfhi(bv.x), bflo(bv.y), bfhi(bv.y), bflo(bv.z), bfhi(bv.z), bflo(bv.w), bfhi(bv.w)};
            float y[8];
#pragma unroll
            for (int e = 0; e < 8; ++e) { y[e] = bb[e] * (w0[e] * hm2[e] + w1[e] * hm1[e] + w2[e] * hc[e]); hm2[e] = hm1[e]; hm1[e] = hc[e]; }
            v4u o; o.x = pk2(y[0], y[1]); o.y = pk2(y[2], y[3]); o.z = pk2(y[4], y[5]); o.w = pk2(y[6], y[7]);
            *(v4u*)(O + (size_t)(t0 + i) * D + c0) = o; }
    }
}

__device__ __forceinline__ void gla_prep_phase(LAS unsigned char* lds, bf16* BIG, bf16* KHg, float* ELg) {
    const int tid = threadIdx.x, c4 = tid & 31, seg = tid >> 5;
    LAS float* SEG = (LAS float*)lds;
    for (int item = blockIdx.x; item < NB * 64 * 4; item += gridDim.x) {
        const int h = item & 3, bc = item >> 2;
        bf16* p = BIG + (size_t)(bc * 64 + 4 * seg) * 3584 + h * 128 + 4 * c4;
        v2u rq[4], rk[4], rg[4];
#pragma unroll
        for (int i = 0; i < 4; ++i) { rq[i] = *(const v2u*)(p + (size_t)i * 3584); rk[i] = *(const v2u*)(p + (size_t)i * 3584 + 512); rg[i] = *(const v2u*)(p + (size_t)i * 3584 + 3072); }
        f32x4 cs[4]; f32x4 run = (f32x4){0.f, 0.f, 0.f, 0.f};
#pragma unroll
        for (int i = 0; i < 4; ++i) { run = run + (f32x4){bflo(rg[i].x), bfhi(rg[i].x), bflo(rg[i].y), bfhi(rg[i].y)}; cs[i] = run; }
        *(LAS f32x4*)(SEG + seg * 128 + 4 * c4) = run;
        LBAR();
        f32x4 prefix = (f32x4){0.f, 0.f, 0.f, 0.f}, last = (f32x4){0.f, 0.f, 0.f, 0.f};
#pragma unroll
        for (int sgi = 0; sgi < 16; ++sgi) { const f32x4 t = *(const LAS f32x4*)(SEG + sgi * 128 + 4 * c4); last = last + t; if (sgi < seg) prefix = prefix + t; }
        float kh[4][4];
#pragma unroll
        for (int i = 0; i < 4; ++i) {
            const f32x4 cum = prefix + cs[i];
            const float qv[4] = {bflo(rq[i].x), bfhi(rq[i].x), bflo(rq[i].y), bfhi(rq[i].y)}, kv[4] = {bflo(rk[i].x), bfhi(rk[i].x), bflo(rk[i].y), bfhi(rk[i].y)};
            float qo[4], ko[4];
#pragma unroll
            for (int e = 0; e < 4; ++e) { qo[e] = qv[e] * __expf(cum[e]) * 0.08838834764831845f; ko[e] = kv[e] * __expf(fminf(-cum[e], 80.f)); kh[e][i] = kv[e] * __expf(last[e] - cum[e]); }
            v2u wq, wk; wq.x = pk2(qo[0], qo[1]); wq.y = pk2(qo[2], qo[3]); wk.x = pk2(ko[0], ko[1]); wk.y = pk2(ko[2], ko[3]);
            *(v2u*)(p + (size_t)i * 3584) = wq; *(v2u*)(p + (size_t)i * 3584 + 512) = wk;
        }
#pragma unroll
        for (int e = 0; e < 4; ++e) { v2u w; w.x = pk2(kh[e][0], kh[e][1]); w.y = pk2(kh[e][2], kh[e][3]); *(v2u*)(KHg + (size_t)item * 8192 + (4 * c4 + e) * 64 + 4 * seg) = w; }
        if (seg == 0) *(f32x4*)(ELg + (size_t)item * 128 + 4 * c4) = (f32x4){__expf(last[0]), __expf(last[1]), __expf(last[2]), __expf(last[3])};
        LBAR();
    }
}

struct GSet { v4u gq[2], gk[2], gh[2]; v2u rv; f32x4 gel; };
__device__ __forceinline__ void gla_phase(LAS unsigned char* lds, const bf16* BIG, const bf16* KHg, const float* ELg, bf16* OR, float* part) {
    const int tid = threadIdx.x, lane = tid & 63, w = __builtin_amdgcn_readfirstlane(tid >> 6);
    LAS bf16* QT = (LAS bf16*)(lds + 0);
    LAS bf16* KT = (LAS bf16*)(lds + 17408);
    LAS bf16* KH = (LAS bf16*)(lds + 34816);
    LAS bf16* VT = (LAS bf16*)(lds + 53248);
    LAS bf16* ST = (LAS bf16*)(lds + 57856);
    LAS float* EL = (LAS float*)(lds + 68608);
    const int vtok = tid >> 3, vdv = (tid & 7) * 4;
    const int r16 = lane & 15, quad = lane >> 4, mi = w >> 1, ni = w & 1;
    const int prow = tid >> 4, pc16 = tid & 15;
    const int kdk = tid >> 3, kc8 = tid & 7;
    for (int item0 = blockIdx.x; item0 < 256; item0 += gridDim.x) {
        const int item = (gridDim.x == 256) ? (((item0 & 7) << 5) | (item0 >> 3)) : item0;
        const int bh = item >> 3, sl = item & 7, b = bh >> 2, h = bh & 3;
        LBAR();
        for (int i = tid; i < 32 * 136 / 2; i += NTHR) ((LAS unsigned*)ST)[i] = 0u;
        f32x4 sacc[2]; sacc[0] = (f32x4){0.f, 0.f, 0.f, 0.f}; sacc[1] = sacc[0];
        const bf16* base = BIG + (size_t)(b * SEQ) * 3584;
        GSet gs[4];
#define GLA_LOAD(S, c) do { const bf16* r0_ = base + (size_t)((c) * 64 + prow) * 3584 + h * 128 + pc16 * 8; const bf16* r1_ = r0_ + (size_t)32 * 3584; \
            S.gq[0] = *(const v4u*)r0_; S.gq[1] = *(const v4u*)r1_; S.gk[0] = *(const v4u*)(r0_ + 512); S.gk[1] = *(const v4u*)(r1_ + 512); \
            const size_t it_ = (size_t)((b * 64 + (c)) * 4 + h); const bf16* kh_ = KHg + it_ * 8192 + kdk * 64 + kc8 * 8; S.gh[0] = *(const v4u*)kh_; S.gh[1] = *(const v4u*)(kh_ + 64 * 64); \
            S.gel = *(const f32x4*)(ELg + it_ * 128 + (tid & 31) * 4); \
            S.rv = *(const v2u*)(base + (size_t)((c) * 64 + vtok) * 3584 + 1024 + h * 256 + sl * 32 + vdv); } while (0)
        GLA_LOAD(gs[0], 0); GLA_LOAD(gs[1], 1); GLA_LOAD(gs[2], 2); GLA_LOAD(gs[3], 3);
        for (int c4 = 0; c4 < 64; c4 += 4) {
#pragma unroll
          for (int kk = 0; kk < 4; ++kk) {
            const int c = c4 + kk;
            const size_t t0 = (size_t)b * SEQ + c * 64;
            *(LAS v4u*)(QT + prow * 136 + pc16 * 8) = gs[kk].gq[0]; *(LAS v4u*)(QT + (prow + 32) * 136 + pc16 * 8) = gs[kk].gq[1];
            *(LAS v4u*)(KT + prow * 136 + pc16 * 8) = gs[kk].gk[0]; *(LAS v4u*)(KT + (prow + 32) * 136 + pc16 * 8) = gs[kk].gk[1];
            *(LAS v4u*)(KH + kdk * 72 + kc8 * 8) = gs[kk].gh[0]; *(LAS v4u*)(KH + (kdk + 64) * 72 + kc8 * 8) = gs[kk].gh[1];
            if (tid < 32) *(LAS f32x4*)(EL + tid * 4) = gs[kk].gel;
            { const v2u rv = gs[kk].rv;
            VT[(vdv + 0) * 72 + vtok] = (bf16)(rv.x & 0xffffu); VT[(vdv + 1) * 72 + vtok] = (bf16)(rv.x >> 16);
            VT[(vdv + 2) * 72 + vtok] = (bf16)(rv.y & 0xffffu); VT[(vdv + 3) * 72 + vtok] = (bf16)(rv.y >> 16); }
            if (c + 4 < 64) GLA_LOAD(gs[kk], c + 4);
            LBAR();
            bf16x8 qa[4];
#pragma unroll
            for (int a = 0; a < 4; ++a) qa[a] = *(const LAS bf16x8*)(QT + (16 * mi + r16) * 136 + 32 * a + 8 * quad);
            f32x4 sc[4];
#pragma unroll
            for (int jt = 0; jt < 4; ++jt) { sc[jt] = (f32x4){0.f, 0.f, 0.f, 0.f};
                if (jt <= mi) {
#pragma unroll
                    for (int a = 0; a < 4; ++a) { const bf16x8 kf = *(const LAS bf16x8*)(KT + (16 * jt + r16) * 136 + 32 * a + 8 * quad); sc[jt] = __builtin_amdgcn_mfma_f32_16x16x32_bf16(kf, qa[a], sc[jt], 0, 0, 0); }
#pragma unroll
                    for (int r = 0; r < 4; ++r) if (16 * jt + 4 * quad + r > 16 * mi + r16) sc[jt][r] = 0.f;
                } }
            f32x4 oacc = (f32x4){0.f, 0.f, 0.f, 0.f};
#pragma unroll
            for (int a = 0; a < 4; ++a) { const bf16x8 sf = *(const LAS bf16x8*)(ST + (16 * ni + r16) * 136 + 32 * a + 8 * quad); oacc = __builtin_amdgcn_mfma_f32_16x16x32_bf16(qa[a], sf, oacc, 0, 0, 0); }
#pragma unroll
            for (int a = 0; a < 2; ++a) {
                v4u pw; pw.x = pk2(sc[2 * a][0], sc[2 * a][1]); pw.y = pk2(sc[2 * a][2], sc[2 * a][3]); pw.z = pk2(sc[2 * a + 1][0], sc[2 * a + 1][1]); pw.w = pk2(sc[2 * a + 1][2], sc[2 * a + 1][3]);
                const bf16x4 vlo = *(const LAS bf16x4*)(VT + (16 * ni + r16) * 72 + 32 * a + 4 * quad), vhi = *(const LAS bf16x4*)(VT + (16 * ni + r16) * 72 + 32 * a + 16 + 4 * quad);
                oacc = __builtin_amdgcn_mfma_f32_16x16x32_bf16(__builtin_bit_cast(bf16x8, pw), CAT4(vlo, vhi), oacc, 0, 0, 0); }
            {   bf16* op = OR + (t0 + 16 * mi + 4 * quad) * D + h * 256 + sl * 32 + 16 * ni + r16;
                float ss[4];
#pragma unroll
                for (int r = 0; r < 4; ++r) { op[(size_t)r * D] = (bf16)f2bf(oacc[r]); ss[r] = oacc[r] * oacc[r]; }
#pragma unroll
                for (int r = 0; r < 4; ++r) {
                    ss[r] += __builtin_bit_cast(float, __builtin_amdgcn_update_dpp(0, __builtin_bit_cast(int, ss[r]), 0x111, 0xf, 0xf, true));
                    ss[r] += __builtin_bit_cast(float, __builtin_amdgcn_update_dpp(0, __builtin_bit_cast(int, ss[r]), 0x112, 0xf, 0xf, true));
                    ss[r] += __builtin_bit_cast(float, __builtin_amdgcn_update_dpp(0, __builtin_bit_cast(int, ss[r]), 0x114, 0xf, 0xf, true));
                    ss[r] += __builtin_bit_cast(float, __builtin_amdgcn_update_dpp(0, __builtin_bit_cast(int, ss[r]), 0x118, 0xf, 0xf, true)); }
                if (r16 == 15) {
#pragma unroll
                    for (int r = 0; r < 4; ++r) part[((t0 + 16 * mi + 4 * quad + r) * 4 + h) * 16 + sl * 2 + ni] = ss[r]; }
            }
#pragma unroll
            for (int tI = 0; tI < 2; ++tI) { const int dk0 = 16 * (2 * mi + tI);
                const f32x4 el = *(const LAS f32x4*)(EL + dk0 + 4 * quad); sacc[tI] = sacc[tI] * el;
#pragma unroll
                for (int a = 0; a < 2; ++a) { const bf16x8 kh = *(const LAS bf16x8*)(KH + (dk0 + r16) * 72 + 32 * a + 8 * quad), vf = *(const LAS bf16x8*)(VT + (16 * ni + r16) * 72 + 32 * a + 8 * quad);
                    sacc[tI] = __builtin_amdgcn_mfma_f32_16x16x32_bf16(kh, vf, sacc[tI], 0, 0, 0); } }
            LBAR();
#pragma unroll
            for (int tI = 0; tI < 2; ++tI) { const int dk0 = 16 * (2 * mi + tI); v2u sw; sw.x = pk2(sacc[tI][0], sacc[tI][1]); sw.y = pk2(sacc[tI][2], sacc[tI][3]);
                *(LAS v2u*)(ST + (16 * ni + r16) * 136 + dk0 + 4 * quad) = sw; }
          }
        }
#undef GLA_LOAD
    }
}

__device__ __forceinline__ void glafin_phase(const bf16* BIG, const float* part, const float* hn, bf16* OR, int gtid, int NT) {
    for (int it = gtid; it < T * 128; it += NT) {
        const int cgp = it & 127, t = it >> 7, c0 = cgp * 8, hd = c0 >> 8;
        const f32x4* pp = (const f32x4*)(part + ((size_t)t * 4 + hd) * 16);
        const f32x4 p0 = pp[0], p1 = pp[1], p2 = pp[2], p3 = pp[3];
        const float ssum = ((p0.x + p0.y) + (p0.z + p0.w)) + ((p1.x + p1.y) + (p1.z + p1.w)) + ((p2.x + p2.y) + (p2.z + p2.w)) + ((p3.x + p3.y) + (p3.z + p3.w));
        const float r = 1.0f / sqrtf(ssum * (1.f / 256.f) + EPS);
        const v4u ov = *(const v4u*)(OR + (size_t)t * D + c0), gv = *(const v4u*)(BIG + (size_t)t * 3584 + 2048 + c0);
        const f32x4 h0 = *(const f32x4*)(hn + c0), h1 = *(const f32x4*)(hn + c0 + 4);
        float o[8] = {bflo(ov.x), bfhi(ov.x), bflo(ov.y), bfhi(ov.y), bflo(ov.z), bfhi(ov.z), bflo(ov.w), bfhi(ov.w)};
        float g[8] = {bflo(gv.x), bfhi(gv.x), bflo(gv.y), bfhi(gv.y), bflo(gv.z), bfhi(gv.z), bflo(gv.w), bfhi(gv.w)};
        float hh[8] = {h0.x, h0.y, h0.z, h0.w, h1.x, h1.y, h1.z, h1.w};
        float y[8];
#pragma unroll
        for (int e = 0; e < 8; ++e) y[e] = o[e] * r * hh[e] * (g[e] / (1.f + __expf(-g[e])));
        v4u w; w.x = pk2(y[0], y[1]); w.y = pk2(y[2], y[3]); w.z = pk2(y[4], y[5]); w.w = pk2(y[6], y[7]);
        *(v4u*)(OR + (size_t)t * D + c0) = w;
    }
}

template <int MODE, int SCALE, int M, int N, int K> __device__ __forceinline__ void run_gemm(LAS unsigned char* lds, const bf16* A, const bf16* Bt, bf16* O, int ldc, const float* bias, const float* rs) {
    pg8::Gemm g{A, Bt, M, N, K}; pg8::StaticOrder S; S.init(M, N, (int)gridDim.x, (int)blockIdx.x);
    pg8::EpiOut<MODE, SCALE> E{O, ldc, bias, rs};
    pg8::gemm_phase<pg8::EpiOut<MODE, SCALE>, pg8::StaticOrder, false, true>(lds, g, S, E);
    if (REP_GEMM == 2) { __syncthreads(); pg8::gemm_phase<pg8::EpiOut<MODE, SCALE>, pg8::StaticOrder, false, true>(lds, g, S, E); }
}

__host__ __device__ inline bool step_active(int st) { if (st == 0) return true; const int L = (st - 1) / 9, sub = (st - 1) % 9, kind = L % 3; if (sub == 1) return kind != 1; if (sub == 3) return kind == 2; return true; }

template <class Tp> __device__ __forceinline__ Tp* as_global(Tp* p) { return (Tp*)(__attribute__((address_space(1))) Tp*)p; }
struct Args { const float* in[14]; float* out; unsigned char* ws; int st_lo, st_hi, coop, pad; };

#define GET_ARGS() const Args* ap = &a_args; \
    unsigned char* ws = as_global(ap->ws); bf16* Wb = (bf16*)(ws + WS_W); bf16* HB = (bf16*)(ws + WS_XN); bf16* MB = (bf16*)(ws + WS_M); bf16* BIG = (bf16*)(ws + WS_BIG); float* part = (float*)(ws + WS_PART); \
    float* rh = (float*)(ws + WS_RH); bf16* OB = (bf16*)as_global(ap->out); \
    (void)Wb; (void)HB; (void)MB; (void)BIG; (void)part; (void)rh; (void)OB
#define GET_IDS() int tid = threadIdx.x; asm volatile("" : "+v"(tid)); const int lane = tid & 63, wave = __builtin_amdgcn_readfirstlane(tid >> 6); \
    const int G = gridDim.x, gw = blockIdx.x * NWAVES + wave, NGW = G * NWAVES, gtid = blockIdx.x * NTHR + tid, NT = G * NTHR; (void)lane; (void)gw; (void)NGW; (void)gtid; (void)NT
#define IN(k) (st_lo <= (k) && (k) < st_hi)
#define SYNC(k) do { if ((k) + 1 < st_hi) xcd_barrier(xbar); } while (0)

template <int L> __device__ __forceinline__ void run_layer(const Args& a_args, LAS unsigned char* lds, const int st_lo, const int st_hi, const XcdBarrier& xbar) {
    constexpr int kind = L % 3, j = L / 3, base = 1 + 9 * L;
    if (IN(base + 0)) { GET_ARGS();
        if constexpr (kind == 0) { run_gemm<0, 1, T, 2048, 1024>(lds, HB, Wb + W_QKV + (size_t)j * 3072 * 1024, BIG, 2048, nullptr, rh); if (base + 1 < st_hi) __syncthreads(); }
        else if constexpr (kind == 1) { run_gemm<0, 1, T, 3072, 1024>(lds, HB, Wb + W_CIN, BIG, 3072, nullptr, rh); SYNC(base + 0); }
        else { run_gemm<2, 1, T, 3584, 1024>(lds, HB, Wb + W_GIN, BIG, 3584, as_global(ap->in[9]), rh); SYNC(base + 0); }
    }
    if constexpr (kind == 2) { if (IN(base + 1)) { GET_ARGS(); gla_prep_phase(lds, BIG, MB, (float*)(ws + WS_M + 32 * MiB)); SYNC(base + 1); } }
    if constexpr (kind == 0) { if (IN(base + 1)) { GET_ARGS();
        run_gemm<0, 2, 1024, T, 1024>(lds, Wb + W_QKV + (size_t)j * 3072 * 1024 + (size_t)2048 * 1024, HB, BIG + (size_t)T * 2048, T, nullptr, rh); SYNC(base + 1); } }
    if (IN(base + 2)) { GET_ARGS(); GET_IDS();
        if constexpr (kind == 0) { for (int rep = 0; rep < REP_ATTN; ++rep) sb_attn_phase(lds, wave, BIG, BIG + (size_t)T * 2048, OB, gw, NGW, lane); }
        else if constexpr (kind == 1) { for (int rep = 0; rep < REP_CONV; ++rep) conv_phase(BIG, as_global(ap->in[5]), OB, gtid, NT); }
        else { for (int rep = 0; rep < REP_GLA; ++rep) gla_phase(lds, BIG, MB, (const float*)(ws + WS_M + 32 * MiB), OB, part); }
        SYNC(base + 2); }
    if constexpr (kind == 2) { if (IN(base + 3)) { GET_ARGS(); GET_IDS(); glafin_phase(BIG, part, as_global(ap->in[10]), OB, gtid, NT); SYNC(base + 3); } }
    if (IN(base + 4)) { GET_ARGS();
        const bf16* Bt = (kind == 0) ? Wb + W_SBO + (size_t)j * 1024 * 1024 : (kind == 1) ? Wb + W_COUT : Wb + W_GO;
        run_gemm<0, 0, T, 1024, 1024>(lds, OB, Bt, MB, 1024, nullptr, nullptr); SYNC(base + 4); }
    if (IN(base + 5)) { GET_ARGS(); GET_IDS(); const float* gains = as_global(ap->in[1]);
        if constexpr (L == 0) resid_pass<true, true, false>(as_global(ap->in[0]), MB, gains + (size_t)(L * 4 + 1) * D, HB, nullptr, rh, gw, NGW, lane);
        else resid_pass<false, true, false>(nullptr, MB, gains + (size_t)(L * 4 + 1) * D, HB, nullptr, rh, gw, NGW, lane);
        SYNC(base + 5); }
    if (IN(base + 6)) { GET_ARGS(); run_gemm<1, 1, T, 4096, 1024>(lds, HB, Wb + W_UP + (size_t)L * 4096 * 1024, BIG, 4096, nullptr, rh); SYNC(base + 6); }
    if (IN(base + 7)) { GET_ARGS(); run_gemm<0, 0, T, 1024, 4096>(lds, BIG, Wb + W_DN + (size_t)L * 1024 * 4096, MB, 1024, nullptr, nullptr); SYNC(base + 7); }
    if (IN(base + 8)) { GET_ARGS(); GET_IDS(); const float* gains = as_global(ap->in[1]);
        if constexpr (L + 1 < DEPTH) resid_pass<false, true, false>(nullptr, MB, gains + (size_t)(L * 4 + 3) * D, HB, nullptr, rh, gw, NGW, lane);
        else resid_pass<false, true, true>(nullptr, MB, gains + (size_t)(L * 4 + 3) * D, HB, as_global(ap->out), nullptr, gw, NGW, lane);
        SYNC(base + 8); }
}

__global__ void __launch_bounds__(NTHR, 2) mega_fwd(Args a_args) {
    extern __shared__ __attribute__((aligned(16))) unsigned char lds_raw[];
    LAS unsigned char* lds = (LAS unsigned char*)lds_raw;
    cg::grid_group grid = cg::this_grid();
    int st_lo, st_hi;
    XcdBarrier xbar; xbar.bar = nullptr; xbar.x = 0; xbar.st = nullptr;
    { const Args* ap0 = &a_args; st_lo = ap0->st_lo; st_hi = ap0->st_hi;
      if (ap0->coop) {
          volatile LAS unsigned* misc = (volatile LAS unsigned*)(lds + 131072);
          if (threadIdx.x < 16) misc[threadIdx.x] = 0u;
          __syncthreads();
          xbar = xcd_barrier_post((unsigned*)(as_global(ap0->ws) + WS_BAR), misc);
      } }
    if (IN(0)) { GET_ARGS(); GET_IDS();
        LAS float* scr = (LAS float*)(lds + wave * 16384);
        constexpr int NITEMS = 2 * 1536 + 2 * 512 + 1536 + 512 + 1536 + 512 + 4 * 2048 + 4 * 2048;
        for (int it = gw; it < NITEMS; it += NGW) {
            int r = it, m = 0;
            for (m = 0; m < 16; ++m) { const int c = (m < 2) ? 1536 : (m < 4) ? 512 : (m == 4) ? 1536 : (m == 5) ? 512 : (m == 6) ? 1536 : (m == 7) ? 512 : 2048; if (r < c) break; r -= c; }
            const float* Wp; int ldw, K, ncols; bf16* dst;
            if (m < 2)       { Wp = as_global(ap->in[2]) + (size_t)m * 1024 * 3072; ldw = 3072; K = 1024; ncols = 3072; dst = Wb + W_QKV + (size_t)m * 3072 * 1024; }
            else if (m < 4)  { Wp = as_global(ap->in[3]) + (size_t)(m - 2) * 1024 * 1024; ldw = 1024; K = 1024; ncols = 1024; dst = Wb + W_SBO + (size_t)(m - 2) * 1024 * 1024; }
            else if (m == 4) { Wp = as_global(ap->in[4]); ldw = 3072; K = 1024; ncols = 3072; dst = Wb + W_CIN; }
            else if (m == 5) { Wp = as_global(ap->in[6]); ldw = 1024; K = 1024; ncols = 1024; dst = Wb + W_COUT; }
            else if (m == 6) { Wp = as_global(ap->in[7]); ldw = 3088; K = 1024; ncols = 3072; dst = Wb + W_GIN; }
            else if (m == 7) { Wp = as_global(ap->in[11]); ldw = 1024; K = 1024; ncols = 1024; dst = Wb + W_GO; }
            else if (m < 12) { Wp = as_global(ap->in[12]) + (size_t)(m - 8) * 1024 * 4096; ldw = 4096; K = 1024; ncols = 4096; dst = Wb + W_UP + (size_t)(m - 8) * 4096 * 1024; }
            else             { Wp = as_global(ap->in[13]) + (size_t)(m - 12) * 4096 * 1024; ldw = 1024; K = 4096; ncols = 1024; dst = Wb + W_DN + (size_t)(m - 12) * 1024 * 4096; }
            const float* gn = as_global(ap->in[1]);
            const float* gk = (m < 2) ? gn + (size_t)(3 * m * 4) * D : (m == 4) ? gn + (size_t)(1 * 4) * D : (m == 6) ? gn + (size_t)(2 * 4) * D : (m >= 8 && m < 12) ? gn + (size_t)((m - 8) * 4 + 2) * D : nullptr;
            transpose_item(Wp, ldw, K, ncols / 32, dst, scr, r, lane, gk, (m < 2) ? 1024 : 0);
        }
        { const float* win = as_global(ap->in[7]); const float* wgu = as_global(ap->in[8]); const float* g2 = as_global(ap->in[1]) + (size_t)(2 * 4) * D;
        for (int it = gw; it < 1024; it += NGW) {
            const int cb = it >> 7, kb = it & 127, c = 64 * cb + lane;
            float wu[16];
#pragma unroll
            for (int r = 0; r < 16; ++r) wu[r] = wgu[r * 512 + c];
            float acc8[8];
#pragma unroll
            for (int kk = 0; kk < 8; ++kk) { const float* ar = win + (size_t)(8 * kb + kk) * 3088 + 3072; float s = 0.f;
#pragma unroll
                for (int r = 0; r < 16; ++r) s += ar[r] * wu[r];
                acc8[kk] = s * g2[8 * kb + kk]; }
            v4u o; o.x = pk2(acc8[0], acc8[1]); o.y = pk2(acc8[2], acc8[3]); o.z = pk2(acc8[4], acc8[5]); o.w = pk2(acc8[6], acc8[7]);
            *(v4u*)(Wb + W_GIN + (size_t)(3072 + c) * 1024 + 8 * kb) = o;
        } }
        resid_pass<true, false, false>(as_global(ap->in[0]), nullptr, nullptr, HB, nullptr, rh, gw, NGW, lane);
    }
    if (IN(0) && 1 < st_hi) xcd_barrier(xbar);
    if (st_hi > 1000000) grid.sync();
    run_layer<0>(a_args, lds, st_lo, st_hi, xbar);
    run_layer<1>(a_args, lds, st_lo, st_hi, xbar);
    run_layer<2>(a_args, lds, st_lo, st_hi, xbar);
    run_layer<3>(a_args, lds, st_lo, st_hi, xbar);
}

extern "C" void kernel_launch(void* const* d_in, const int* in_sizes, int n_in, void* d_out, int out_size, void* d_ws, size_t ws_size, hipStream_t stream) {
    static int grid = 0;
    if (grid == 0) {
        if (n_in != 14 || in_sizes[0] != T * D || out_size != T * D || ws_size < WS_END) { fprintf(stderr, "kernel_launch: unexpected shapes (n_in %d, in0 %d, out %d, ws %zu need %zu)\n", n_in, n_in > 0 ? in_sizes[0] : -1, out_size, ws_size, (size_t)WS_END); grid = -1; return; }
        int dev = 0, cus = 0, per_cu = 0;
        if (hipGetDevice(&dev) != hipSuccess || hipDeviceGetAttribute(&cus, hipDeviceAttributeMultiprocessorCount, dev) != hipSuccess) { fprintf(stderr, "kernel_launch: device query failed\n"); grid = -1; return; }
        if (hipFuncSetAttribute((const void*)mega_fwd, hipFuncAttributeMaxDynamicSharedMemorySize, LDS_BYTES) != hipSuccess) { fprintf(stderr, "kernel_launch: hipFuncSetAttribute failed\n"); grid = -1; return; }
        if (hipOccupancyMaxActiveBlocksPerMultiprocessor(&per_cu, (const void*)mega_fwd, NTHR, LDS_BYTES) != hipSuccess || per_cu < 1) { fprintf(stderr, "kernel_launch: occupancy query says %d\n", per_cu); per_cu = 1; }
        (void)hipGetLastError();
        grid = cus * per_cu;
    }
    if (grid < 0) return;
    Args a{};
    for (int i = 0; i < 14; ++i) a.in[i] = (const float*)d_in[i];
    a.out = (float*)d_out; a.ws = (unsigned char*)d_ws;
#if MK_COOP
    if (hipMemsetAsync((char*)d_ws + WS_BAR, 0, 16384, stream) != hipSuccess) { fprintf(stderr, "kernel_launch: memset failed\n"); return; }
    a.st_lo = 0; a.st_hi = NSTEPS; a.coop = 1;
    void* args[] = {&a};
    hipError_t e = hipLaunchCooperativeKernel((const void*)mega_fwd, dim3(grid), dim3(NTHR), args, LDS_BYTES, stream);
    if (e != hipSuccess) fprintf(stderr, "kernel_launch: cooperative launch failed: %s (grid %d)\n", hipGetErrorString(e), grid);
#else
    for (int st = 0; st < NSTEPS; ++st) { if (!step_active(st)) continue;
        a.st_lo = st; a.st_hi = st + 1; a.coop = 0;
        hipLaunchKernelGGL(mega_fwd, dim3(grid), dim3(NTHR), LDS_BYTES, stream, a); }
#endif
}
```

```cpp
#include <hip/hip_runtime.h>
#include <hip/hip_cooperative_groups.h>
#include <cstdio>
#include <cstdint>
namespace cg = cooperative_groups;
namespace pg8 {
#define PG8_LAS __attribute__((address_space(3)))
typedef unsigned short bf16_t;
typedef short bf16x8 __attribute__((ext_vector_type(8)));
typedef float f32x4 __attribute__((ext_vector_type(4)));
typedef unsigned u32x4 __attribute__((ext_vector_type(4)));
constexpr int BM = 256, BK = 64, HALF = 128, HTB = HALF * BK * 2  , STAGE_BYTES = 8 * HTB, NXCD = 8, WGM = 4;

__host__ __device__ __forceinline__ int lds_byte(int r, int c) { const int st = (r >> 4) * 2 + (c >> 5), rr = r & 15, cc = c & 31, ob = rr * 64 + cc * 2; return st * 1024 + (ob ^ (((ob >> 9) & 1) << 5)); }
__host__ __device__ __forceinline__ void stage_rc(int b, int& R, int& C) { const int st = b / 1024, sb = b % 1024, swz = sb ^ (((sb >> 9) & 1) << 5); R = (st >> 1) * 16 + swz / 64; C = (st & 1) * 32 + (swz % 64) / 2; }
__host__ __device__ __forceinline__ int perm32(int rho) { const int n = rho >> 4, i = rho & 15; return 8 * (i >> 2) + 4 * n + (i & 3); }

struct Unit { int pm, pn; };
struct Gemm { const bf16_t* A; const bf16_t* Bt; int M, N, K; };

struct StaticOrder {
    int nM, nN, nwg, G, c;
    __host__ __device__ void init(int M, int N, int G_, int c_) { nM = M / BM; nN = N / BM; nwg = nM * nN; G = G_; c = c_; }
    __host__ __device__ bool next(int i, Unit& u) const {
        const long L = (long)i * G + c; if (L >= nwg) return false;
        int wgid = (int)L; { const int q = nwg / NXCD, r = nwg % NXCD, xcd = wgid % NXCD, off = wgid / NXCD; wgid = (xcd < r ? xcd * (q + 1) : r * (q + 1) + (xcd - r) * q) + off; }
        const int nig = WGM * nN, gid = wgid / nig, fm = gid * WGM, gsz = (nM - fm) < WGM ? (nM - fm) : WGM;
        u.pm = fm + ((wgid % nig) % gsz); u.pn = (wgid % nig) / gsz; return true;
    }
    __device__ __forceinline__ void a_ready(const Unit&) const {}
    __device__ __forceinline__ void done(const Unit&) const {}
};

__device__ __forceinline__ unsigned cvt_pk_bf16(float lo, float hi) { unsigned r; asm volatile("v_cvt_pk_bf16_f32 %0, %1, %2" : "=v"(r) : "v"(lo), "v"(hi)); return r; }
template <int MODE, int SCALE> struct EpiOut {
    static constexpr bool PERM = true, AFTER_DRAIN = false;
    bf16_t* O; int ldc; const float* bias; const float* rs;
    __device__ __forceinline__ void operator()(const f32x4 (&acc)[2][2][4][2], const Unit& u, int wr, int wc, int fr, int fq) const {
        const int row0 = u.pm * BM + wr * 64 + fr; const int col0 = u.pn * BM + wc * 32 + 8 * fq;
        const bool gate = (MODE == 2) && (u.pn >= 12);
        f32x4 bv[2][2], cs[2][2]; float rsv[2][4];
#pragma unroll
        for (int bj = 0; bj < 2; ++bj)
#pragma unroll
            for (int n = 0; n < 2; ++n) { bv[bj][n] = gate ? *(const f32x4*)(bias + (col0 - 3072) + bj * HALF + 4 * n) : (f32x4){0.f, 0.f, 0.f, 0.f};
                if (SCALE == 2) cs[bj][n] = *(const f32x4*)(rs + col0 + bj * HALF + 4 * n); else cs[bj][n] = (f32x4){1.f, 1.f, 1.f, 1.f}; }
#pragma unroll
        for (int ai = 0; ai < 2; ++ai)
#pragma unroll
            for (int m = 0; m < 4; ++m) { if (SCALE == 1) rsv[ai][m] = rs[row0 + ai * HALF + m * 16]; else rsv[ai][m] = 1.f; }
#pragma unroll
        for (int ai = 0; ai < 2; ++ai)
#pragma unroll
            for (int m = 0; m < 4; ++m) { bf16_t* rowp = O + (size_t)(row0 + ai * HALF + m * 16) * ldc + col0;
#pragma unroll
                for (int bj = 0; bj < 2; ++bj) { f32x4 v0 = acc[ai][bj][m][0], v1 = acc[ai][bj][m][1];
                    if (SCALE == 1) { v0 = v0 * rsv[ai][m]; v1 = v1 * rsv[ai][m]; }
                    if (SCALE == 2) { v0 = v0 * cs[bj][0]; v1 = v1 * cs[bj][1]; }
                    if (MODE == 1) {
#pragma unroll
                        for (int j = 0; j < 4; ++j) { const float a = fmaxf(v0[j], 0.f), b = fmaxf(v1[j], 0.f); v0[j] = a * a; v1[j] = b * b; } }
                    if (MODE == 2) { if (gate) { v0 = v0 + bv[bj][0]; v1 = v1 + bv[bj][1];
#pragma unroll
                        for (int j = 0; j < 4; ++j) { const float a = v0[j], b = v1[j];
                            v0[j] = (fminf(a, 0.f) - __logf(1.f + __expf(-fabsf(a)))) * 0.0625f; v1[j] = (fminf(b, 0.f) - __logf(1.f + __expf(-fabsf(b)))) * 0.0625f; } } }
                    u32x4 w; w.x = cvt_pk_bf16(v0[0], v0[1]); w.y = cvt_pk_bf16(v0[2], v0[3]); w.z = cvt_pk_bf16(v1[0], v1[1]); w.w = cvt_pk_bf16(v1[2], v1[3]);
                    *(u32x4*)(rowp + bj * HALF) = w; } }
    }
};

template <class Epi, class Sched, bool ALIGN_EPI = false, bool SP2 = false>
__device__ __forceinline__ void gemm_phase(PG8_LAS unsigned char* lds, const Gemm g, const Sched& S, const Epi& E) {
    int tid = threadIdx.x; asm volatile("" : "+v"(tid));
    const int wid = __builtin_amdgcn_readfirstlane(tid >> 6), lane = tid & 63, wr = wid >> 2, wc = wid & 3, fr = lane & 15, fq = lane >> 4;
    const int K = g.K, nt = K / BK;
    unsigned voffA[2], voffB[2];
#pragma unroll
    for (int i = 0; i < 2; ++i) { int R, C; stage_rc(tid * 16 + i * 8192, R, C); const int Rb = Epi::PERM ? ((R & ~31) + perm32(R & 31)) : R;
        voffA[i] = (unsigned)(R * K + C) * 2u; voffB[i] = (unsigned)(Rb * K + C) * 2u; }
    const size_t kstep = (size_t)(BK * 2);
    const size_t hstep = (size_t)HALF * K * 2;
    const size_t tstep = 2 * hstep;
    const unsigned ldsw = (unsigned)wid * 1024u;
    const int aoff = lds_byte(wr * 64 + fr, fq * 8), boff = lds_byte(wc * 32 + fr, fq * 8);
#define PG8_SA(b, h) (((b) * 2 + (h)) * HTB)
#define PG8_SB(b, h) ((4 + (b) * 2 + (h)) * HTB)
#define PG8_STAGE(bufoff, gbase, voff) do { _Pragma("unroll") for (int _i = 0; _i < 2; ++_i) \
        __builtin_amdgcn_global_load_lds((const unsigned*)((const char*)(gbase) + (voff)[_i]), (PG8_LAS unsigned*)(lds + (bufoff) + ldsw + _i * 8192), 16, 0, 0); } while (0)
#define PG8_LDA(dst, b, h) do { _Pragma("unroll") for (int m = 0; m < 4; ++m) _Pragma("unroll") for (int k = 0; k < 2; ++k) dst[m][k] = *(const PG8_LAS bf16x8*)(lds + PG8_SA(b, h) + aoff + m * 2048 + k * 1024); } while (0)
#define PG8_LDB(dst, b, h) do { _Pragma("unroll") for (int n = 0; n < 2; ++n) _Pragma("unroll") for (int k = 0; k < 2; ++k) dst[n][k] = *(const PG8_LAS bf16x8*)(lds + PG8_SB(b, h) + boff + n * 2048 + k * 1024); } while (0)
#define PG8_MMA(ai, bj, At, Bt) do { __builtin_amdgcn_s_setprio(1); _Pragma("unroll") for (int m = 0; m < 4; ++m) _Pragma("unroll") for (int n = 0; n < 2; ++n) _Pragma("unroll") for (int k = 0; k < 2; ++k) \
        acc[ai][bj][m][n] = __builtin_amdgcn_mfma_f32_16x16x32_bf16(Bt[n][k], At[m][k], acc[ai][bj][m][n], 0, 0, 0); __builtin_amdgcn_s_setprio(0); } while (0)
#define PG8_WAIT_V(n) asm volatile("s_waitcnt vmcnt(" #n ")" ::: "memory")
#define PG8_WAIT_L(n) asm volatile("s_waitcnt lgkmcnt(" #n ")" ::: "memory")
#define PG8_BAR __builtin_amdgcn_s_barrier()
#define PG8_SCHED __builtin_amdgcn_sched_barrier(0)
    Unit cur, nxt; int ui = 0;
    if (!S.next(0, cur)) return;
    f32x4 acc[2][2][4][2];
#pragma unroll
    for (int a = 0; a < 2; ++a)
#pragma unroll
        for (int b = 0; b < 2; ++b)
#pragma unroll
            for (int m = 0; m < 4; ++m)
#pragma unroll
                for (int n = 0; n < 2; ++n) acc[a][b][m][n] = (f32x4){0.f, 0.f, 0.f, 0.f};
    bf16x8 At[4][2], B0[2][2], B1[2][2];
    const char* cA = (const char*)g.A + (size_t)cur.pm * tstep; const char* cB = (const char*)g.Bt + (size_t)cur.pn * tstep;
    S.a_ready(cur);
    if constexpr (SP2) {
        PG8_STAGE(PG8_SB(0, 0), cB, voffB); PG8_STAGE(PG8_SB(0, 1), cB + hstep, voffB); PG8_STAGE(PG8_SA(0, 0), cA, voffA); PG8_STAGE(PG8_SA(0, 1), cA + hstep, voffA);
        if (wr == 1) PG8_BAR;
        PG8_WAIT_V(2); PG8_BAR;
        PG8_STAGE(PG8_SB(1, 0), cB + kstep, voffB); PG8_STAGE(PG8_SA(1, 0), cA + kstep, voffA); PG8_STAGE(PG8_SB(1, 1), cB + hstep + kstep, voffB);
        PG8_WAIT_V(6); PG8_BAR;
    } else {
        PG8_STAGE(PG8_SB(0, 0), cB, voffB); PG8_STAGE(PG8_SA(0, 0), cA, voffA); PG8_STAGE(PG8_SB(0, 1), cB + hstep, voffB); PG8_STAGE(PG8_SA(0, 1), cA + hstep, voffA);
        if (wr == 1) PG8_BAR;
        PG8_WAIT_V(4); PG8_BAR;
        PG8_STAGE(PG8_SB(1, 0), cB + kstep, voffB); PG8_STAGE(PG8_SA(1, 0), cA + kstep, voffA); PG8_STAGE(PG8_SB(1, 1), cB + hstep + kstep, voffB);
        PG8_WAIT_V(6); PG8_BAR;
    }
    for (;;) {
        const bool has_next = S.next(ui + 1, nxt);
        const char* nA = has_next ? (const char*)g.A + (size_t)nxt.pm * tstep : cA; const char* nB = has_next ? (const char*)g.Bt + (size_t)nxt.pn * tstep : cB;
        for (int t = 0; t < nt; t += 2) {
            const bool last = (t == nt - 2);
            const char* a1 = cA + (size_t)(t + 1) * kstep;
            const char* a2 = last ? nA : cA + (size_t)(t + 2) * kstep; const char* b2 = last ? nB : cB + (size_t)(t + 2) * kstep;
            const char* a3 = a2 + kstep; const char* b3 = b2 + kstep;
            if (last && has_next) S.a_ready(nxt);
            if constexpr (SP2) {
            PG8_LDB(B0, 0, 0); PG8_LDB(B1, 0, 1); PG8_SCHED; PG8_LDA(At, 0, 0); PG8_STAGE(PG8_SA(1, 1), a1 + hstep, voffA);
            PG8_WAIT_V(8); PG8_WAIT_L(0); PG8_BAR; PG8_MMA(0, 0, At, B0); PG8_MMA(0, 1, At, B1); PG8_BAR; PG8_SCHED;
            PG8_LDA(At, 0, 1); PG8_STAGE(PG8_SB(0, 0), b2, voffB); PG8_STAGE(PG8_SB(0, 1), b2 + hstep, voffB); PG8_STAGE(PG8_SA(0, 0), a2, voffA);
            PG8_WAIT_V(8); PG8_WAIT_L(0); PG8_BAR; PG8_MMA(1, 0, At, B0); PG8_MMA(1, 1, At, B1); PG8_BAR; PG8_SCHED;
            PG8_LDB(B0, 1, 0); PG8_LDB(B1, 1, 1); PG8_SCHED; PG8_LDA(At, 1, 0); PG8_STAGE(PG8_SA(0, 1), a2 + hstep, voffA);
            PG8_WAIT_V(8); PG8_WAIT_L(0); PG8_BAR; PG8_MMA(0, 0, At, B0); PG8_MMA(0, 1, At, B1); PG8_BAR; PG8_SCHED;
            PG8_LDA(At, 1, 1); PG8_STAGE(PG8_SB(1, 0), b3, voffB); PG8_STAGE(PG8_SB(1, 1), b3 + hstep, voffB); PG8_STAGE(PG8_SA(1, 0), a3, voffA);
            PG8_WAIT_V(8); PG8_WAIT_L(0); PG8_BAR; PG8_MMA(1, 0, At, B0); PG8_MMA(1, 1, At, B1); PG8_BAR; PG8_SCHED;
            } else {
            PG8_LDB(B0, 0, 0); PG8_SCHED; PG8_LDA(At, 0, 0); PG8_STAGE(PG8_SA(1, 1), a1 + hstep, voffA);
            PG8_WAIT_L(8); PG8_BAR; PG8_WAIT_L(0); PG8_MMA(0, 0, At, B0); PG8_BAR; PG8_SCHED;
            PG8_LDB(B1, 0, 1); PG8_STAGE(PG8_SB(0, 0), b2, voffB);
            PG8_BAR; PG8_WAIT_L(0); PG8_MMA(0, 1, At, B1); PG8_BAR;
            PG8_LDA(At, 0, 1); PG8_STAGE(PG8_SA(0, 0), a2, voffA);
            PG8_BAR; PG8_WAIT_L(0); PG8_MMA(1, 0, At, B0); PG8_BAR; PG8_SCHED;
            PG8_STAGE(PG8_SB(0, 1), b2 + hstep, voffB);
            PG8_WAIT_V(6); PG8_BAR; PG8_MMA(1, 1, At, B1); PG8_BAR;
            PG8_LDB(B0, 1, 0); PG8_SCHED; PG8_LDA(At, 1, 0); PG8_STAGE(PG8_SA(0, 1), a2 + hstep, voffA);
            PG8_WAIT_L(8); PG8_BAR; PG8_WAIT_L(0); PG8_MMA(0, 0, At, B0); PG8_BAR; PG8_SCHED;
            PG8_LDB(B1, 1, 1); PG8_STAGE(PG8_SB(1, 0), b3, voffB);
            PG8_BAR; PG8_WAIT_L(0); PG8_MMA(0, 1, At, B1); PG8_BAR;
            PG8_LDA(At, 1, 1); PG8_STAGE(PG8_SA(1, 0), a3, voffA);
            PG8_BAR; PG8_WAIT_L(0); PG8_MMA(1, 0, At, B0); PG8_BAR; PG8_SCHED;
            PG8_STAGE(PG8_SB(1, 1), b3 + hstep, voffB);
            PG8_WAIT_V(6); PG8_BAR; PG8_MMA(1, 1, At, B1); PG8_BAR;
            }
        }
        if constexpr (ALIGN_EPI) { if (wr == 0) PG8_BAR; }
        if constexpr (!Epi::AFTER_DRAIN) { E(acc, cur, wr, wc, fr, fq); S.done(cur); }
        if (!has_next) break;
#pragma unroll
        for (int a = 0; a < 2; ++a)
#pragma unroll
            for (int b = 0; b < 2; ++b)
#pragma unroll
                for (int m = 0; m < 4; ++m)
#pragma unroll
                    for (int n = 0; n < 2; ++n) acc[a][b][m][n] = (f32x4){0.f, 0.f, 0.f, 0.f};
        cur = nxt; cA = nA; cB = nB; ++ui;
        if constexpr (ALIGN_EPI) { if (wr == 1) PG8_BAR; }
    }
    PG8_WAIT_V(0);
    if constexpr (!ALIGN_EPI) { if (wr == 0) PG8_BAR; }
    PG8_BAR;
    if constexpr (Epi::AFTER_DRAIN) { E.fused(acc, cur, wr, wc, fr, fq, lds, wid, lane); S.done(cur); }
#undef PG8_SA
#undef PG8_SB
#undef PG8_STAGE
#undef PG8_LDA
#undef PG8_LDB
#undef PG8_MMA
#undef PG8_WAIT_V
#undef PG8_WAIT_L
#undef PG8_BAR
#undef PG8_SCHED
}
}

#define LAS __attribute__((address_space(3)))
typedef unsigned short bf16;
typedef unsigned v4u __attribute__((ext_vector_type(4)));
typedef unsigned v2u __attribute__((ext_vector_type(2)));
typedef float f32x4 __attribute__((ext_vector_type(4)));
typedef float f32x16 __attribute__((ext_vector_type(16)));
typedef short bf16x8 __attribute__((ext_vector_type(8)));
typedef short bf16x4 __attribute__((ext_vector_type(4)));

#ifndef REP_ATTN
#define REP_ATTN 1
#endif
#ifndef REP_GLA
#define REP_GLA 1
#endif
#ifndef REP_GEMM
#define REP_GEMM 1
#endif
#ifndef REP_CONV
#define REP_CONV 1
#endif
#ifndef MK_COOP
#define MK_COOP 1
#endif

constexpr int NB = 8, SEQ = 4096, T = NB * SEQ, D = 1024, FF = 4096, DEPTH = 4;
constexpr float EPS = 1e-6f;
constexpr int NWAVES = 8, NTHR = 512;
constexpr int LDS_BYTES = 131072 + 2048;
constexpr int NSTEPS = 1 + 9 * DEPTH;

constexpr size_t MiB = (size_t)1 << 20;
constexpr size_t WS_BAR = 0;
constexpr size_t WS_RH = 512 * 1024;
constexpr size_t WS_PART = 1 * MiB;
constexpr size_t WS_W = 10 * MiB;
constexpr size_t W_QKV = 0;
constexpr size_t W_SBO = W_QKV + (size_t)2 * 3072 * 1024;
constexpr size_t W_CIN = W_SBO + (size_t)2 * 1024 * 1024;
constexpr size_t W_COUT = W_CIN + (size_t)3072 * 1024;
constexpr size_t W_GIN = W_COUT + (size_t)1024 * 1024;
constexpr size_t W_GO = W_GIN + (size_t)3584 * 1024;
constexpr size_t W_UP = W_GO + (size_t)1024 * 1024;
constexpr size_t W_DN = W_UP + (size_t)4 * 4096 * 1024;
constexpr size_t W_END = W_DN + (size_t)4 * 4096 * 1024;
constexpr size_t WS_XN = 108 * MiB;
constexpr size_t WS_M = 172 * MiB;
constexpr size_t WS_BIG = 236 * MiB;
constexpr size_t WS_END = 492 * MiB;
static_assert(WS_W + W_END * 2 <= WS_XN, "weights fit");

#define LDS_WAIT() asm volatile("s_waitcnt lgkmcnt(0)" ::: "memory")
#define LBAR() do { asm volatile("s_waitcnt lgkmcnt(0)" ::: "memory"); __builtin_amdgcn_s_barrier(); asm volatile("" ::: "memory"); } while (0)
__device__ __forceinline__ unsigned f2bf(float f) { unsigned u = __builtin_bit_cast(unsigned, f); return (u + 0x7fffu + ((u >> 16) & 1u)) >> 16; }
__device__ __forceinline__ unsigned pk2(float lo, float hi) { return pg8::cvt_pk_bf16(lo, hi); }
__device__ __forceinline__ float bf2f(unsigned short b) { return __builtin_bit_cast(float, ((unsigned)b) << 16); }
__device__ __forceinline__ float bflo(unsigned w) { return __builtin_bit_cast(float, w << 16); }
__device__ __forceinline__ float bfhi(unsigned w) { return __builtin_bit_cast(float, w & 0xffff0000u); }
__device__ __forceinline__ float wave_sum(float v) {
#pragma unroll
    for (int o = 1; o < 64; o <<= 1) v += __shfl_xor(v, o);
    return v;
}

#define XB_TMO      128
#define XB_XCNT(j)  (256  + 64 * (j))
#define XB_XSUB(j)  (1280 + 64 * (j))
#define XB_XGEN(j)  (2304 + 64 * (j))
#define XB_TOP      3328
#define XB_TOPGEN   3392
#define XCD_BAR_WORDS 3456
#define XB_SPIN_CAP (1u << 18)

__device__ __forceinline__ unsigned xb_ld(unsigned* p)              { return __hip_atomic_load(p, __ATOMIC_RELAXED, __HIP_MEMORY_SCOPE_AGENT); }
__device__ __forceinline__ unsigned xb_add(unsigned* p, unsigned v) { return __hip_atomic_fetch_add(p, v, __ATOMIC_RELAXED, __HIP_MEMORY_SCOPE_AGENT); }
__device__ __forceinline__ unsigned xb_xcc_id() { return (unsigned)__builtin_amdgcn_s_getreg((3 << 11) | 20) & 0xFu; }
#define XB_SPIN(cond, bar) do { unsigned _sp = 0; while (cond) { __builtin_amdgcn_s_sleep(1); \
    if ((++_sp & 255u) == 0u) { if (xb_ld(&(bar)[XB_TMO])) break; if (_sp > XB_SPIN_CAP) { atomicAdd(&(bar)[XB_TMO], 1u); break; } } } } while (0)

struct XcdBarrier {
    unsigned* bar; unsigned x;
    volatile LAS unsigned* st;
};

__device__ __forceinline__ XcdBarrier xcd_barrier_post(unsigned* bar, volatile LAS unsigned* st) {
    XcdBarrier b; b.bar = bar; b.x = xb_xcc_id(); b.st = st;
    if (threadIdx.x == 0) (void)xb_add(&bar[XB_XCNT(b.x)], 1u);
    return b;
}
__device__ __forceinline__ void xcd_barrier_complete(unsigned* bar, unsigned x, unsigned& nloc, unsigned& nx) {
    const unsigned G = gridDim.x * gridDim.y * gridDim.z;
    unsigned sum, cnt, mine, sp = 0u;
    for (;;) {
        sum = 0u; cnt = 0u; mine = 0u;
#pragma unroll
        for (unsigned j = 0; j < 16; ++j) { const unsigned c = xb_ld(&bar[XB_XCNT(j)]); sum += c; cnt += (c > 0u) ? 1u : 0u; mine = (j == x) ? c : mine; }
        if (sum == G) break;
        __builtin_amdgcn_s_sleep(1);
        if ((++sp & 255u) == 0u) { if (xb_ld(&bar[XB_TMO])) break; if (sp > XB_SPIN_CAP) { atomicAdd(&bar[XB_TMO], 1u); break; } }
    }
    nloc = mine > 0u ? mine : 1u; nx = cnt > 0u ? cnt : 1u;
}

__device__ __forceinline__ void xcd_barrier(const XcdBarrier& b) {
    asm volatile("s_waitcnt vmcnt(0)" ::: "memory");
    __syncthreads();
    if (threadIdx.x == 0) {
        unsigned* bar = b.bar;
        __builtin_amdgcn_s_waitcnt(0);
        unsigned nloc = b.st[0], nx = b.st[1];
        if (nloc == 0u) { xcd_barrier_complete(bar, b.x, nloc, nx); b.st[0] = nloc; b.st[1] = nx; }
        const unsigned old = xb_add(&bar[XB_XSUB(b.x)], 1u);
        const unsigned gen = old / nloc;
        if (old + 1u == (gen + 1u) * nloc) {
            __builtin_amdgcn_fence(__ATOMIC_RELEASE, "agent");
            asm volatile("s_waitcnt vmcnt(0)" ::: "memory");
            const unsigned og = xb_add(&bar[XB_TOP], 1u);
            const unsigned tg = og / nx;
            if (og + 1u == (tg + 1u) * nx) xb_add(&bar[XB_TOPGEN], 1u);
            else XB_SPIN(xb_ld(&bar[XB_TOPGEN]) == tg, bar);
            __builtin_amdgcn_fence(__ATOMIC_ACQUIRE, "agent");
            xb_add(&bar[XB_XGEN(b.x)], 1u);
            asm volatile("s_waitcnt vmcnt(0)" ::: "memory");
        } else {
            XB_SPIN(xb_ld(&bar[XB_XGEN(b.x)]) == gen, bar);
            __builtin_amdgcn_fence(__ATOMIC_ACQUIRE, "agent");
            asm volatile("s_waitcnt vmcnt(0)" ::: "memory");
        }
    }
    __syncthreads();
}

__device__ __forceinline__ void transpose_item(const float* W, int ldw, int K, int nblk, bf16* WT, LAS float* scr, int item, int lane, const float* gk, int nscale) {
    const int kb = item / nblk, nb = item % nblk, k0 = 64 * kb, n0 = 32 * nb;
    float tv[32];
#pragma unroll
    for (int i = 0; i < 32; ++i) { const int kk = 2 * i + (lane >> 5); tv[i] = __builtin_nontemporal_load(W + (size_t)(k0 + kk) * ldw + n0 + (lane & 31)); }
    if (gk) {
#pragma unroll
        for (int i = 0; i < 32; ++i) { const int kk = 2 * i + (lane >> 5); tv[i] *= gk[k0 + kk]; } }
    if (n0 < nscale) {
#pragma unroll
        for (int i = 0; i < 32; ++i) tv[i] *= 0.18033688011112042f; }
#pragma unroll
    for (int i = 0; i < 32; ++i) { const int kk = 2 * i + (lane >> 5); scr[kk * 33 + (lane & 31)] = tv[i]; }
    LDS_WAIT();
    const int c = lane & 7;
#pragma unroll
    for (int j = 0; j < 4; ++j) { const int n = (lane >> 3) + 8 * j; const LAS float* s = scr + (8 * c) * 33 + n;
        v4u o; o.x = pk2(s[0 * 33], s[1 * 33]); o.y = pk2(s[2 * 33], s[3 * 33]); o.z = pk2(s[4 * 33], s[5 * 33]); o.w = pk2(s[6 * 33], s[7 * 33]);
        *(v4u*)(WT + (size_t)(n0 + n) * K + k0 + 8 * c) = o; }
    LDS_WAIT();
}

template <bool HIN_F32, bool HAS_M, bool FINAL>
__device__ __forceinline__ void resid_pass(const float* hin32, const bf16* m, const float* g_post, bf16* hb, float* out32, float* rh, int gw, int NGW, int lane) {
    for (int row0 = gw; row0 < T; row0 += 2 * NGW) {
        const int row1 = row0 + NGW; const bool two = row1 < T; const int r1 = two ? row1 : row0;
        f32x4 v0[4], v1[4];
        if (HIN_F32) { const f32x4* hp0 = (const f32x4*)(hin32 + (size_t)row0 * D) + lane; const f32x4* hp1 = (const f32x4*)(hin32 + (size_t)r1 * D) + lane;
#pragma unroll
            for (int j = 0; j < 4; ++j) { v0[j] = hp0[64 * j]; v1[j] = hp1[64 * j]; } }
        else { const v2u* hp0 = (const v2u*)(hb + (size_t)row0 * D) + lane; const v2u* hp1 = (const v2u*)(hb + (size_t)r1 * D) + lane; v2u a[4], b[4];
#pragma unroll
            for (int j = 0; j < 4; ++j) { a[j] = hp0[64 * j]; b[j] = hp1[64 * j]; }
#pragma unroll
            for (int j = 0; j < 4; ++j) { v0[j] = (f32x4){bflo(a[j].x), bfhi(a[j].x), bflo(a[j].y), bfhi(a[j].y)}; v1[j] = (f32x4){bflo(b[j].x), bfhi(b[j].x), bflo(b[j].y), bfhi(b[j].y)}; } }
        if (HAS_M) {
            const v2u* mp0 = (const v2u*)(m + (size_t)row0 * D) + lane; const v2u* mp1 = (const v2u*)(m + (size_t)r1 * D) + lane;
            v2u w0[4], w1[4];
#pragma unroll
            for (int j = 0; j < 4; ++j) { w0[j] = __builtin_nontemporal_load(mp0 + 64 * j); w1[j] = __builtin_nontemporal_load(mp1 + 64 * j); }
            f32x4 gp[4];
#pragma unroll
            for (int j = 0; j < 4; ++j) gp[j] = ((const f32x4*)g_post)[lane + 64 * j];
            f32x4 a0[4], a1[4]; float s0 = 0.f, s1 = 0.f;
#pragma unroll
            for (int j = 0; j < 4; ++j) { a0[j] = (f32x4){bflo(w0[j].x), bfhi(w0[j].x), bflo(w0[j].y), bfhi(w0[j].y)}; a1[j] = (f32x4){bflo(w1[j].x), bfhi(w1[j].x), bflo(w1[j].y), bfhi(w1[j].y)};
                s0 += (a0[j].x * a0[j].x + a0[j].y * a0[j].y) + (a0[j].z * a0[j].z + a0[j].w * a0[j].w); s1 += (a1[j].x * a1[j].x + a1[j].y * a1[j].y) + (a1[j].z * a1[j].z + a1[j].w * a1[j].w); }
#pragma unroll
            for (int o = 1; o < 64; o <<= 1) { s0 += __shfl_xor(s0, o); s1 += __shfl_xor(s1, o); }
            const float rm0 = 1.0f / sqrtf(s0 * (1.f / D) + EPS), rm1 = 1.0f / sqrtf(s1 * (1.f / D) + EPS);
#pragma unroll
            for (int j = 0; j < 4; ++j) { v0[j] = v0[j] + a0[j] * rm0 * gp[j]; v1[j] = v1[j] + a1[j] * rm1 * gp[j]; }
        }
        if (FINAL) {
            f32x4* op0 = (f32x4*)(out32 + (size_t)row0 * D) + lane; f32x4* op1 = (f32x4*)(out32 + (size_t)r1 * D) + lane;
#pragma unroll
            for (int j = 0; j < 4; ++j) { op0[64 * j] = v0[j]; if (two) op1[64 * j] = v1[j]; }
        } else {
            float s0 = 0.f, s1 = 0.f;
#pragma unroll
            for (int j = 0; j < 4; ++j) { s0 += (v0[j].x * v0[j].x + v0[j].y * v0[j].y) + (v0[j].z * v0[j].z + v0[j].w * v0[j].w); s1 += (v1[j].x * v1[j].x + v1[j].y * v1[j].y) + (v1[j].z * v1[j].z + v1[j].w * v1[j].w); }
#pragma unroll
            for (int o = 1; o < 64; o <<= 1) { s0 += __shfl_xor(s0, o); s1 += __shfl_xor(s1, o); }
            if (lane == 0) { rh[row0] = 1.0f / sqrtf(s0 * (1.f / D) + EPS); if (two) rh[row1] = 1.0f / sqrtf(s1 * (1.f / D) + EPS); }
            v2u* xp0 = (v2u*)(hb + (size_t)row0 * D) + lane; v2u* xp1 = (v2u*)(hb + (size_t)r1 * D) + lane;
#pragma unroll
            for (int j = 0; j < 4; ++j) { v2u w; w.x = pk2(v0[j].x, v0[j].y); w.y = pk2(v0[j].z, v0[j].w); xp0[64 * j] = w;
                if (two) { v2u u; u.x = pk2(v1[j].x, v1[j].y); u.y = pk2(v1[j].z, v1[j].w); xp1[64 * j] = u; } }
        }
    }
}

#define CAT4(lo, hi) ((bf16x8){lo[0], lo[1], lo[2], lo[3], hi[0], hi[1], hi[2], hi[3]})
struct SbRaw { v4u k[4]; v4u v[4]; };
template <bool DIAG> __device__ __forceinline__ void sb_tile(const f32x16& st, const int hb, const int qrel, float& C, bf16x8& pa0, bf16x8& pa1) {
    float r[16], be[16];
#pragma unroll
    for (int i = 0; i < 16; ++i) { const float e = __builtin_amdgcn_exp2f(st[i]); const float rr = __builtin_amdgcn_rcpf(1.f + e);
        if (DIAG) { const int kap = 8 * (i >> 2) + 4 * hb + (i & 3); const bool vis = kap < qrel; r[i] = vis ? rr : 1.f; be[i] = vis ? 1.f - rr : 0.f; }
        else { r[i] = rr; be[i] = 1.f - rr; } }
    float pg[4], og[4];
#pragma unroll
    for (int g = 0; g < 4; ++g) pg[g] = (r[4 * g] * r[4 * g + 1]) * (r[4 * g + 2] * r[4 * g + 3]);
#pragma unroll
    for (int g = 0; g < 4; ++g) {
        const unsigned xb = __builtin_bit_cast(unsigned, pg[g]); const auto r = __builtin_amdgcn_permlane32_swap(xb, xb, false, false);
        og[g] = __builtin_bit_cast(float, hb ? (unsigned)r[0] : (unsigned)r[1]); }
    float E[4]; float run = C;
#pragma unroll
    for (int g = 3; g >= 0; --g) { E[g] = (hb == 0) ? run * og[g] : run; run *= pg[g] * og[g]; }
    C = run;
    float wv[16];
#pragma unroll
    for (int g = 0; g < 4; ++g) { float S = E[g];
#pragma unroll
        for (int q = 3; q >= 0; --q) { const int i = 4 * g + q; wv[i] = be[i] * S; S *= r[i]; } }
    v4u t0; t0.x = pk2(wv[0], wv[1]); t0.y = pk2(wv[2], wv[3]); t0.z = pk2(wv[4], wv[5]); t0.w = pk2(wv[6], wv[7]); pa0 = __builtin_bit_cast(bf16x8, t0);
    v4u t1; t1.x = pk2(wv[8], wv[9]); t1.y = pk2(wv[10], wv[11]); t1.z = pk2(wv[12], wv[13]); t1.w = pk2(wv[14], wv[15]); pa1 = __builtin_bit_cast(bf16x8, t1);
}
__device__ __forceinline__ void sb_attn_phase(LAS unsigned char* lds, int wave, const bf16* QK, const bf16* VTg, bf16* O, int gw, int NGW, int lane) {
    const int n = lane & 31, hb = lane >> 5;
    LAS bf16* Kb = (LAS bf16*)(lds + wave * 10240);
    LAS bf16* Vb = Kb + 32 * 72;
    for (int u0 = gw; u0 < NB * 16 * 128; u0 += NGW) {
        int u = u0;
        if (NGW == 2048) { const int blk = u0 >> 3 & 255, wv = u0 & 7, rnd = u0 >> 11; u = ((blk & 7) << 11) | (rnd << 8) | ((blk >> 3) << 3) | wv; }
        const int qb = u & 127, bh = u >> 7, h = bh & 15, b = bh >> 4;
        const int q0 = qb * 32; const size_t tok0 = (size_t)b * SEQ;
        bf16x8 qf[4];
        {
            const bf16* qg = QK + (tok0 + q0 + (lane >> 3)) * 2048 + h * 64 + 8 * (lane & 7);
            v4u qv[4];
#pragma unroll
            for (int i = 0; i < 4; ++i) qv[i] = *(const v4u*)(qg + (size_t)(8 * i) * 2048);
#pragma unroll
            for (int i = 0; i < 4; ++i) *(LAS v4u*)(Kb + (8 * i + (lane >> 3)) * 72 + 8 * (lane & 7)) = qv[i];
#pragma unroll
            for (int s = 0; s < 4; ++s) qf[s] = *(const LAS bf16x8*)(Kb + n * 72 + 16 * s + 8 * hb);
        }
        f32x16 o0, o1;
#pragma unroll
        for (int i = 0; i < 16; ++i) { o0[i] = 0.f; o1[i] = 0.f; }
        float C = 1.f;
        const int kr = lane >> 3, kc = lane & 7, vr = lane >> 2, vc = lane & 3;
        const bf16* kg = QK + (tok0 + kr) * 2048 + 1024 + h * 64 + 8 * kc;
        const bf16* vg = VTg + (size_t)(h * 64 + vr) * T + tok0 + 8 * vc;
        SbRaw ks[2];
#define SB_LOAD(S, k0_) do { \
            _Pragma("unroll") for (int i = 0; i < 4; ++i) { S.k[i] = *(const v4u*)(kg + (size_t)((k0_) + 8 * i) * 2048); S.v[i] = *(const v4u*)(vg + (size_t)(16 * i) * T + (k0_)); } } while (0)
        SB_LOAD(ks[0], q0);
        if (qb >= 1) SB_LOAD(ks[1], q0 - 32);
        int kt = qb; bool done = false;
        while (!done) {
#pragma unroll
            for (int j = 0; j < 2; ++j) {
#pragma unroll
                for (int i = 0; i < 4; ++i) { *(LAS v4u*)(Kb + (8 * i + kr) * 72 + 8 * kc) = ks[j].k[i]; *(LAS v4u*)(Vb + (16 * i + vr) * 40 + 8 * vc) = ks[j].v[i]; }
                if (kt >= 2) SB_LOAD(ks[j], (kt - 2) * 32);
                bf16x8 kf[4]; bf16x4 va[2][4];
#pragma unroll
                for (int s = 0; s < 4; ++s) kf[s] = *(const LAS bf16x8*)(Kb + n * 72 + 16 * s + 8 * hb);
#pragma unroll
                for (int p = 0; p < 4; ++p) { va[0][p] = *(const LAS bf16x4*)(Vb + n * 40 + 8 * p + 4 * hb); va[1][p] = *(const LAS bf16x4*)(Vb + (32 + n) * 40 + 8 * p + 4 * hb); }
                f32x16 st;
#pragma unroll
                for (int i = 0; i < 16; ++i) st[i] = 0.f;
#pragma unroll
                for (int s = 0; s < 4; ++s) st = __builtin_amdgcn_mfma_f32_32x32x16_bf16(kf[s], qf[s], st, 0, 0, 0);
                bf16x8 pa0, pa1;
                if (kt == qb) sb_tile<true>(st, hb, n, C, pa0, pa1);
                else sb_tile<false>(st, hb, 0, C, pa0, pa1);
                o0 = __builtin_amdgcn_mfma_f32_32x32x16_bf16(pa0, CAT4(va[0][0], va[0][1]), o0, 0, 0, 0);
                o0 = __builtin_amdgcn_mfma_f32_32x32x16_bf16(pa1, CAT4(va[0][2], va[0][3]), o0, 0, 0, 0);
                o1 = __builtin_amdgcn_mfma_f32_32x32x16_bf16(pa0, CAT4(va[1][0], va[1][1]), o1, 0, 0, 0);
                o1 = __builtin_amdgcn_mfma_f32_32x32x16_bf16(pa1, CAT4(va[1][2], va[1][3]), o1, 0, 0, 0);
                if (kt == 0 || __all(C < 1.17549435e-38f)) { done = true; break; }
                --kt;
            }
        }
#undef SB_LOAD
        {
#pragma unroll
            for (int i = 0; i < 16; ++i) { const int row = 8 * (i >> 2) + 4 * hb + (i & 3); Kb[row * 72 + n] = (bf16)f2bf(o0[i]); Kb[row * 72 + 32 + n] = (bf16)f2bf(o1[i]); }
            bf16* og = O + (tok0 + q0 + (lane >> 3)) * D + h * 64 + 8 * (lane & 7);
#pragma unroll
            for (int i = 0; i < 4; ++i) { const v4u w = *(const LAS v4u*)(Kb + (8 * i + (lane >> 3)) * 72 + 8 * (lane & 7)); *(v4u*)(og + (size_t)(8 * i) * D) = w; }
        }
    }
}

__device__ __forceinline__ void conv_phase(const bf16* BIG, const float* cw, bf16* O, int gtid, int NT) {
    for (int it = gtid; it < (T / 8) * 128; it += NT) {
        const int cgp = it & 127, tb = it >> 7, t0 = tb * 8, c0 = cgp * 8;
        float w0[8], w1[8], w2[8], hm2[8], hm1[8];
#pragma unroll
        for (int e = 0; e < 8; ++e) { w0[e] = cw[c0 + e]; w1[e] = cw[D + c0 + e]; w2[e] = cw[2 * D + c0 + e]; hm2[e] = 0.f; hm1[e] = 0.f; }
        if ((t0 & (SEQ - 1)) != 0) {
#pragma unroll
            for (int p = 0; p < 2; ++p) { const bf16* rp = BIG + (size_t)(t0 - 2 + p) * 3072 + c0; const v4u cv = *(const v4u*)(rp + 1024), uv = *(const v4u*)(rp + 2048);
                float hc[8] = {bflo(cv.x) * bflo(uv.x), bfhi(cv.x) * bfhi(uv.x), bflo(cv.y) * bflo(uv.y), bfhi(cv.y) * bfhi(uv.y), bflo(cv.z) * bflo(uv.z), bfhi(cv.z) * bfhi(uv.z), bflo(cv.w) * bflo(uv.w), bfhi(cv.w) * bfhi(uv.w)};
#pragma unroll
                for (int e = 0; e < 8; ++e) { if (p == 0) hm2[e] = hc[e]; else hm1[e] = hc[e]; } }
        }
#pragma unroll
        for (int i = 0; i < 8; ++i) { const bf16* rp = BIG + (size_t)(t0 + i) * 3072 + c0; const v4u bv = __builtin_nontemporal_load((const v4u*)rp), cv = __builtin_nontemporal_load((const v4u*)(rp + 1024)), uv = __builtin_nontemporal_load((const v4u*)(rp + 2048));
            float hc[8] = {bflo(cv.x) * bflo(uv.x), bfhi(cv.x) * bfhi(uv.x), bflo(cv.y) * bflo(uv.y), bfhi(cv.y) * bfhi(uv.y), bflo(cv.z) * bflo(uv.z), bfhi(cv.z) * bfhi(uv.z), bflo(cv.w) * bflo(uv.w), bfhi(cv.w) * bfhi(uv.w)};
            float bb[8] = {bflo(bv.x), bfhi(bv.x), bflo(bv.y), bfhi(bv.y), bflo(bv.z), bfhi(bv.z), bflo(bv.w), bfhi(bv.w)};
            float y[8];
#pragma unroll
            for (int e = 0; e < 8; ++e) { y[e] = bb[e] * (w0[e] * hm2[e] + w1[e] * hm1[e] + w2[e] * hc[e]); hm2[e] = hm1[e]; hm1[e] = hc[e]; }
            v4u o; o.x = pk2(y[0], y[1]); o.y = pk2(y[2], y[3]); o.z = pk2(y[4], y[5]); o.w = pk2(y[6], y[7]);
            *(v4u*)(O + (size_t)(t0 + i) * D + c0) = o; }
    }
}

__device__ __forceinline__ void gla_prep_phase(LAS unsigned char* lds, bf16* BIG, bf16* KHg, float* ELg) {
    const int tid = threadIdx.x, c4 = tid & 31, seg = tid >> 5;
    LAS float* SEG = (LAS float*)lds;
    for (int item = blockIdx.x; item < NB * 64 * 4; item += gridDim.x) {
        const int h = item & 3, bc = item >> 2;
        bf16* p = BIG + (size_t)(bc * 64 + 4 * seg) * 3584 + h * 128 + 4 * c4;
        v2u rq[4], rk[4], rg[4];
#pragma unroll
        for (int i = 0; i < 4; ++i) { rq[i] = *(const v2u*)(p + (size_t)i * 3584); rk[i] = *(const v2u*)(p + (size_t)i * 3584 + 512); rg[i] = *(const v2u*)(p + (size_t)i * 3584 + 3072); }
        f32x4 cs[4]; f32x4 run = (f32x4){0.f, 0.f, 0.f, 0.f};
#pragma unroll
        for (int i = 0; i < 4; ++i) { run = run + (f32x4){bflo(rg[i].x), bfhi(rg[i].x), bflo(rg[i].y), bfhi(rg[i].y)}; cs[i] = run; }
        *(LAS f32x4*)(SEG + seg * 128 + 4 * c4) = run;
        LBAR();
        f32x4 prefix = (f32x4){0.f, 0.f, 0.f, 0.f}, last = (f32x4){0.f, 0.f, 0.f, 0.f};
#pragma unroll
        for (int sgi = 0; sgi < 16; ++sgi) { const f32x4 t = *(const LAS f32x4*)(SEG + sgi * 128 + 4 * c4); last = last + t; if (sgi < seg) prefix = prefix + t; }
        float kh[4][4];
#pragma unroll
        for (int i = 0; i < 4; ++i) {
            const f32x4 cum = prefix + cs[i];
            const float qv[4] = {bflo(rq[i].x), bfhi(rq[i].x), bflo(rq[i].y), bfhi(rq[i].y)}, kv[4] = {bflo(rk[i].x), bfhi(rk[i].x), bflo(rk[i].y), bfhi(rk[i].y)};
            float qo[4], ko[4];
#pragma unroll
            for (int e = 0; e < 4; ++e) { qo[e] = qv[e] * __expf(cum[e]) * 0.08838834764831845f; ko[e] = kv[e] * __expf(fminf(-cum[e], 80.f)); kh[e][i] = kv[e] * __expf(last[e] - cum[e]); }
            v2u wq, wk; wq.x = pk2(qo[0], qo[1]); wq.y = pk2(qo[2], qo[3]); wk.x = pk2(ko[0], ko[1]); wk.y = pk2(ko[2], ko[3]);
            *(v2u*)(p + (size_t)i * 3584) = wq; *(v2u*)(p + (size_t)i * 3584 + 512) = wk;
        }
#pragma unroll
        for (int e = 0; e < 4; ++e) { v2u w; w.x = pk2(kh[e][0], kh[e][1]); w.y = pk2(kh[e][2], kh[e][3]); *(v2u*)(KHg + (size_t)item * 8192 + (4 * c4 + e) * 64 + 4 * seg) = w; }
        if (seg == 0) *(f32x4*)(ELg + (size_t)item * 128 + 4 * c4) = (f32x4){__expf(last[0]), __expf(last[1]), __expf(last[2]), __expf(last[3])};
        LBAR();
    }
}

struct GSet { v4u gq[2], gk[2], gh[2]; v2u rv; f32x4 gel; };
__device__ __forceinline__ void gla_phase(LAS unsigned char* lds, const bf16* BIG, const bf16* KHg, const float* ELg, bf16* OR, float* part) {
    const int tid = threadIdx.x, lane = tid & 63, w = __builtin_amdgcn_readfirstlane(tid >> 6);
    LAS bf16* QT = (LAS bf16*)(lds + 0);
    LAS bf16* KT = (LAS bf16*)(lds + 17408);
    LAS bf16* KH = (LAS bf16*)(lds + 34816);
    LAS bf16* VT = (LAS bf16*)(lds + 53248);
    LAS bf16* ST = (LAS bf16*)(lds + 57856);
    LAS float* EL = (LAS float*)(lds + 68608);
    const int vtok = tid >> 3, vdv = (tid & 7) * 4;
    const int r16 = lane & 15, quad = lane >> 4, mi = w >> 1, ni = w & 1;
    const int prow = tid >> 4, pc16 = tid & 15;
    const int kdk = tid >> 3, kc8 = tid & 7;
    for (int item0 = blockIdx.x; item0 < 256; item0 += gridDim.x) {
        const int item = (gridDim.x == 256) ? (((item0 & 7) << 5) | (item0 >> 3)) : item0;
        const int bh = item >> 3, sl = item & 7, b = bh >> 2, h = bh & 3;
        LBAR();
        for (int i = tid; i < 32 * 136 / 2; i += NTHR) ((LAS unsigned*)ST)[i] = 0u;
        f32x4 sacc[2]; sacc[0] = (f32x4){0.f, 0.f, 0.f, 0.f}; sacc[1] = sacc[0];
        const bf16* base = BIG + (size_t)(b * SEQ) * 3584;
        GSet gs[4];
#define GLA_LOAD(S, c) do { const bf16* r0_ = base + (size_t)((c) * 64 + prow) * 3584 + h * 128 + pc16 * 8; const bf16* r1_ = r0_ + (size_t)32 * 3584; \
            S.gq[0] = *(const v4u*)r0_; S.gq[1] = *(const v4u*)r1_; S.gk[0] = *(const v4u*)(r0_ + 512); S.gk[1] = *(const v4u*)(r1_ + 512); \
            const size_t it_ = (size_t)((b * 64 + (c)) * 4 + h); const bf16* kh_ = KHg + it_ * 8192 + kdk * 64 + kc8 * 8; S.gh[0] = *(const v4u*)kh_; S.gh[1] = *(const v4u*)(kh_ + 64 * 64); \
            S.gel = *(const f32x4*)(ELg + it_ * 128 + (tid & 31) * 4); \
            S.rv = *(const v2u*)(base + (size_t)((c) * 64 + vtok) * 3584 + 1024 + h * 256 + sl * 32 + vdv); } while (0)
        GLA_LOAD(gs[0], 0); GLA_LOAD(gs[1], 1); GLA_LOAD(gs[2], 2); GLA_LOAD(gs[3], 3);
        for (int c4 = 0; c4 < 64; c4 += 4) {
#pragma unroll
          for (int kk = 0; kk < 4; ++kk) {
            const int c = c4 + kk;
            const size_t t0 = (size_t)b * SEQ + c * 64;
            *(LAS v4u*)(QT + prow * 136 + pc16 * 8) = gs[kk].gq[0]; *(LAS v4u*)(QT + (prow + 32) * 136 + pc16 * 8) = gs[kk].gq[1];
            *(LAS v4u*)(KT + prow * 136 + pc16 * 8) = gs[kk].gk[0]; *(LAS v4u*)(KT + (prow + 32) * 136 + pc16 * 8) = gs[kk].gk[1];
            *(LAS v4u*)(KH + kdk * 72 + kc8 * 8) = gs[kk].gh[0]; *(LAS v4u*)(KH + (kdk + 64) * 72 + kc8 * 8) = gs[kk].gh[1];
            if (tid < 32) *(LAS f32x4*)(EL + tid * 4) = gs[kk].gel;
            { const v2u rv = gs[kk].rv;
            VT[(vdv + 0) * 72 + vtok] = (bf16)(rv.x & 0xffffu); VT[(vdv + 1) * 72 + vtok] = (bf16)(rv.x >> 16);
            VT[(vdv + 2) * 72 + vtok] = (bf16)(rv.y & 0xffffu); VT[(vdv + 3) * 72 + vtok] = (bf16)(rv.y >> 16); }
            if (c + 4 < 64) GLA_LOAD(gs[kk], c + 4);
            LBAR();
            bf16x8 qa[4];
#pragma unroll
            for (int a = 0; a < 4; ++a) qa[a] = *(const LAS bf16x8*)(QT + (16 * mi + r16) * 136 + 32 * a + 8 * quad);
            f32x4 sc[4];
#pragma unroll
            for (int jt = 0; jt < 4; ++jt) { sc[jt] = (f32x4){0.f, 0.f, 0.f, 0.f};
                if (jt <= mi) {
#pragma unroll
                    for (int a = 0; a < 4; ++a) { const bf16x8 kf = *(const LAS bf16x8*)(KT + (16 * jt + r16) * 136 + 32 * a + 8 * quad); sc[jt] = __builtin_amdgcn_mfma_f32_16x16x32_bf16(kf, qa[a], sc[jt], 0, 0, 0); }
#pragma unroll
                    for (int r = 0; r < 4; ++r) if (16 * jt + 4 * quad + r > 16 * mi + r16) sc[jt][r] = 0.f;
                } }
            f32x4 oacc = (f32x4){0.f, 0.f, 0.f, 0.f};
#pragma unroll
            for (int a = 0; a < 4; ++a) { const bf16x8 sf = *(const LAS bf16x8*)(ST + (16 * ni + r16) * 136 + 32 * a + 8 * quad); oacc = __builtin_amdgcn_mfma_f32_16x16x32_bf16(qa[a], sf, oacc, 0, 0, 0); }
#pragma unroll
            for (int a = 0; a < 2; ++a) {
                v4u pw; pw.x = pk2(sc[2 * a][0], sc[2 * a][1]); pw.y = pk2(sc[2 * a][2], sc[2 * a][3]); pw.z = pk2(sc[2 * a + 1][0], sc[2 * a + 1][1]); pw.w = pk2(sc[2 * a + 1][2], sc[2 * a + 1][3]);
                const bf16x4 vlo = *(const LAS bf16x4*)(VT + (16 * ni + r16) * 72 + 32 * a + 4 * quad), vhi = *(const LAS bf16x4*)(VT + (16 * ni + r16) * 72 + 32 * a + 16 + 4 * quad);
                oacc = __builtin_amdgcn_mfma_f32_16x16x32_bf16(__builtin_bit_cast(bf16x8, pw), CAT4(vlo, vhi), oacc, 0, 0, 0); }
            {   bf16* op = OR + (t0 + 16 * mi + 4 * quad) * D + h * 256 + sl * 32 + 16 * ni + r16;
                float ss[4];
#pragma unroll
                for (int r = 0; r < 4; ++r) { op[(size_t)r * D] = (bf16)f2bf(oacc[r]); ss[r] = oacc[r] * oacc[r]; }
#pragma unroll
                for (int o = 1; o < 16; o <<= 1) {
#pragma unroll
                    for (int r = 0; r < 4; ++r) ss[r] += __shfl_xor(ss[r], o); }
                if (r16 == 0) {
#pragma unroll
                    for (int r = 0; r < 4; ++r) part[((t0 + 16 * mi + 4 * quad + r) * 4 + h) * 16 + sl * 2 + ni] = ss[r]; }
            }
#pragma unroll
            for (int tI = 0; tI < 2; ++tI) { const int dk0 = 16 * (2 * mi + tI);
                const f32x4 el = *(const LAS f32x4*)(EL + dk0 + 4 * quad); sacc[tI] = sacc[tI] * el;
#pragma unroll
                for (int a = 0; a < 2; ++a) { const bf16x8 kh = *(const LAS bf16x8*)(KH + (dk0 + r16) * 72 + 32 * a + 8 * quad), vf = *(const LAS bf16x8*)(VT + (16 * ni + r16) * 72 + 32 * a + 8 * quad);
                    sacc[tI] = __builtin_amdgcn_mfma_f32_16x16x32_bf16(kh, vf, sacc[tI], 0, 0, 0); } }
            LBAR();
#pragma unroll
            for (int tI = 0; tI < 2; ++tI) { const int dk0 = 16 * (2 * mi + tI); v2u sw; sw.x = pk2(sacc[tI][0], sacc[tI][1]); sw.y = pk2(sacc[tI][2], sacc[tI][3]);
                *(LAS v2u*)(ST + (16 * ni + r16) * 136 + dk0 + 4 * quad) = sw; }
          }
        }
#undef GLA_LOAD
    }
}

__device__ __forceinline__ void glafin_phase(const bf16* BIG, const float* part, const float* hn, bf16* OR, int gtid, int NT) {
    for (int it = gtid; it < T * 128; it += NT) {
        const int cgp = it & 127, t = it >> 7, c0 = cgp * 8, hd = c0 >> 8;
        const f32x4* pp = (const f32x4*)(part + ((size_t)t * 4 + hd) * 16);
        const f32x4 p0 = pp[0], p1 = pp[1], p2 = pp[2], p3 = pp[3];
        const float ssum = ((p0.x + p0.y) + (p0.z + p0.w)) + ((p1.x + p1.y) + (p1.z + p1.w)) + ((p2.x + p2.y) + (p2.z + p2.w)) + ((p3.x + p3.y) + (p3.z + p3.w));
        const float r = 1.0f / sqrtf(ssum * (1.f / 256.f) + EPS);
        const v4u ov = *(const v4u*)(OR + (size_t)t * D + c0), gv = __builtin_nontemporal_load((const v4u*)(BIG + (size_t)t * 3584 + 2048 + c0));
        const f32x4 h0 = *(const f32x4*)(hn + c0), h1 = *(const f32x4*)(hn + c0 + 4);
        float o[8] = {bflo(ov.x), bfhi(ov.x), bflo(ov.y), bfhi(ov.y), bflo(ov.z), bfhi(ov.z), bflo(ov.w), bfhi(ov.w)};
        float g[8] = {bflo(gv.x), bfhi(gv.x), bflo(gv.y), bfhi(gv.y), bflo(gv.z), bfhi(gv.z), bflo(gv.w), bfhi(gv.w)};
        float hh[8] = {h0.x, h0.y, h0.z, h0.w, h1.x, h1.y, h1.z, h1.w};
        float y[8];
#pragma unroll
        for (int e = 0; e < 8; ++e) y[e] = o[e] * r * hh[e] * (g[e] / (1.f + __expf(-g[e])));
        v4u w; w.x = pk2(y[0], y[1]); w.y = pk2(y[2], y[3]); w.z = pk2(y[4], y[5]); w.w = pk2(y[6], y[7]);
        *(v4u*)(OR + (size_t)t * D + c0) = w;
    }
}

template <int MODE, int SCALE, int M, int N, int K> __device__ __forceinline__ void run_gemm(LAS unsigned char* lds, const bf16* A, const bf16* Bt, bf16* O, int ldc, const float* bias, const float* rs) {
    pg8::Gemm g{A, Bt, M, N, K}; pg8::StaticOrder S; S.init(M, N, (int)gridDim.x, (int)blockIdx.x);
    pg8::EpiOut<MODE, SCALE> E{O, ldc, bias, rs};
    pg8::gemm_phase<pg8::EpiOut<MODE, SCALE>, pg8::StaticOrder, false, true>(lds, g, S, E);
    if (REP_GEMM == 2) { __syncthreads(); pg8::gemm_phase<pg8::EpiOut<MODE, SCALE>, pg8::StaticOrder, false, true>(lds, g, S, E); }
}

__host__ __device__ inline bool step_active(int st) { if (st == 0) return true; const int L = (st - 1) / 9, sub = (st - 1) % 9, kind = L % 3; if (sub == 1) return kind != 1; if (sub == 3) return kind == 2; return true; }

template <class Tp> __device__ __forceinline__ Tp* as_global(Tp* p) { return (Tp*)(__attribute__((address_space(1))) Tp*)p; }
struct Args { const float* in[14]; float* out; unsigned char* ws; int st_lo, st_hi, coop, pad; };

#define GET_ARGS() const Args* ap = &a_args; \
    unsigned char* ws = as_global(ap->ws); bf16* Wb = (bf16*)(ws + WS_W); bf16* HB = (bf16*)(ws + WS_XN); bf16* MB = (bf16*)(ws + WS_M); bf16* BIG = (bf16*)(ws + WS_BIG); float* part = (float*)(ws + WS_PART); \
    float* rh = (float*)(ws + WS_RH); bf16* OB = (bf16*)as_global(ap->out); \
    (void)Wb; (void)HB; (void)MB; (void)BIG; (void)part; (void)rh; (void)OB
#define GET_IDS() int tid = threadIdx.x; asm volatile("" : "+v"(tid)); const int lane = tid & 63, wave = __builtin_amdgcn_readfirstlane(tid >> 6); \
    const int G = gridDim.x, gw = blockIdx.x * NWAVES + wave, NGW = G * NWAVES, gtid = blockIdx.x * NTHR + tid, NT = G * NTHR; (void)lane; (void)gw; (void)NGW; (void)gtid; (void)NT
#define IN(k) (st_lo <= (k) && (k) < st_hi)
#define SYNC(k) do { if ((k) + 1 < st_hi) xcd_barrier(xbar); } while (0)

template <int L> __device__ __forceinline__ void run_layer(const Args& a_args, LAS unsigned char* lds, const int st_lo, const int st_hi, const XcdBarrier& xbar) {
    constexpr int kind = L % 3, j = L / 3, base = 1 + 9 * L;
    if (IN(base + 0)) { GET_ARGS();
        if constexpr (kind == 0) { run_gemm<0, 1, T, 2048, 1024>(lds, HB, Wb + W_QKV + (size_t)j * 3072 * 1024, BIG, 2048, nullptr, rh); if (base + 1 < st_hi) __syncthreads(); }
        else if constexpr (kind == 1) { run_gemm<0, 1, T, 3072, 1024>(lds, HB, Wb + W_CIN, BIG, 3072, nullptr, rh); SYNC(base + 0); }
        else { run_gemm<2, 1, T, 3584, 1024>(lds, HB, Wb + W_GIN, BIG, 3584, as_global(ap->in[9]), rh); SYNC(base + 0); }
    }
    if constexpr (kind == 2) { if (IN(base + 1)) { GET_ARGS(); gla_prep_phase(lds, BIG, MB, (float*)(ws + WS_M + 32 * MiB)); SYNC(base + 1); } }
    if constexpr (kind == 0) { if (IN(base + 1)) { GET_ARGS();
        run_gemm<0, 2, 1024, T, 1024>(lds, Wb + W_QKV + (size_t)j * 3072 * 1024 + (size_t)2048 * 1024, HB, BIG + (size_t)T * 2048, T, nullptr, rh); SYNC(base + 1); } }
    if (IN(base + 2)) { GET_ARGS(); GET_IDS();
        if constexpr (kind == 0) { for (int rep = 0; rep < REP_ATTN; ++rep) sb_attn_phase(lds, wave, BIG, BIG + (size_t)T * 2048, OB, gw, NGW, lane); }
        else if constexpr (kind == 1) { for (int rep = 0; rep < REP_CONV; ++rep) conv_phase(BIG, as_global(ap->in[5]), OB, gtid, NT); }
        else { for (int rep = 0; rep < REP_GLA; ++rep) gla_phase(lds, BIG, MB, (const float*)(ws + WS_M + 32 * MiB), OB, part); }
        SYNC(base + 2); }
    if constexpr (kind == 2) { if (IN(base + 3)) { GET_ARGS(); GET_IDS(); glafin_phase(BIG, part, as_global(ap->in[10]), OB, gtid, NT); SYNC(base + 3); } }
    if (IN(base + 4)) { GET_ARGS();
        const bf16* Bt = (kind == 0) ? Wb + W_SBO + (size_t)j * 1024 * 1024 : (kind == 1) ? Wb + W_COUT : Wb + W_GO;
        run_gemm<0, 0, T, 1024, 1024>(lds, OB, Bt, MB, 1024, nullptr, nullptr); SYNC(base + 4); }
    if (IN(base + 5)) { GET_ARGS(); GET_IDS(); const float* gains = as_global(ap->in[1]);
        if constexpr (L == 0) resid_pass<true, true, false>(as_global(ap->in[0]), MB, gains + (size_t)(L * 4 + 1) * D, HB, nullptr, rh, gw, NGW, lane);
        else resid_pass<false, true, false>(nullptr, MB, gains + (size_t)(L * 4 + 1) * D, HB, nullptr, rh, gw, NGW, lane);
        SYNC(base + 5); }
    if (IN(base + 6)) { GET_ARGS(); run_gemm<1, 1, T, 4096, 1024>(lds, HB, Wb + W_UP + (size_t)L * 4096 * 1024, BIG, 4096, nullptr, rh); SYNC(base + 6); }
    if (IN(base + 7)) { GET_ARGS(); run_gemm<0, 0, T, 1024, 4096>(lds, BIG, Wb + W_DN + (size_t)L * 1024 * 4096, MB, 1024, nullptr, nullptr); SYNC(base + 7); }
    if (IN(base + 8)) { GET_ARGS(); GET_IDS(); const float* gains = as_global(ap->in[1]);
        if constexpr (L + 1 < DEPTH) resid_pass<false, true, false>(nullptr, MB, gains + (size_t)(L * 4 + 3) * D, HB, nullptr, rh, gw, NGW, lane);
        else resid_pass<false, true, true>(nullptr, MB, gains + (size_t)(L * 4 + 3) * D, HB, as_global(ap->out), nullptr, gw, NGW, lane);
        SYNC(base + 8); }
}

__global__ void __launch_bounds__(NTHR, 2) mega_fwd(Args a_args) {
    extern __shared__ __attribute__((aligned(16))) unsigned char lds_raw[];
    LAS unsigned char* lds = (LAS unsigned char*)lds_raw;
    cg::grid_group grid = cg::this_grid();
    int st_lo, st_hi;
    XcdBarrier xbar; xbar.bar = nullptr; xbar.x = 0; xbar.st = nullptr;
    { const Args* ap0 = &a_args; st_lo = ap0->st_lo; st_hi = ap0->st_hi;
      if (ap0->coop) {
          volatile LAS unsigned* misc = (volatile LAS unsigned*)(lds + 131072);
          if (threadIdx.x < 16) misc[threadIdx.x] = 0u;
          __syncthreads();
          xbar = xcd_barrier_post((unsigned*)(as_global(ap0->ws) + WS_BAR), misc);
      } }
    if (IN(0)) { GET_ARGS(); GET_IDS();
        LAS float* scr = (LAS float*)(lds + wave * 16384);
        constexpr int NITEMS = 2 * 1536 + 2 * 512 + 1536 + 512 + 1536 + 512 + 4 * 2048 + 4 * 2048;
        for (int it = gw; it < NITEMS; it += NGW) {
            int r = it, m = 0;
            for (m = 0; m < 16; ++m) { const int c = (m < 2) ? 1536 : (m < 4) ? 512 : (m == 4) ? 1536 : (m == 5) ? 512 : (m == 6) ? 1536 : (m == 7) ? 512 : 2048; if (r < c) break; r -= c; }
            const float* Wp; int ldw, K, ncols; bf16* dst;
            if (m < 2)       { Wp = as_global(ap->in[2]) + (size_t)m * 1024 * 3072; ldw = 3072; K = 1024; ncols = 3072; dst = Wb + W_QKV + (size_t)m * 3072 * 1024; }
            else if (m < 4)  { Wp = as_global(ap->in[3]) + (size_t)(m - 2) * 1024 * 1024; ldw = 1024; K = 1024; ncols = 1024; dst = Wb + W_SBO + (size_t)(m - 2) * 1024 * 1024; }
            else if (m == 4) { Wp = as_global(ap->in[4]); ldw = 3072; K = 1024; ncols = 3072; dst = Wb + W_CIN; }
            else if (m == 5) { Wp = as_global(ap->in[6]); ldw = 1024; K = 1024; ncols = 1024; dst = Wb + W_COUT; }
            else if (m == 6) { Wp = as_global(ap->in[7]); ldw = 3088; K = 1024; ncols = 3072; dst = Wb + W_GIN; }
            else if (m == 7) { Wp = as_global(ap->in[11]); ldw = 1024; K = 1024; ncols = 1024; dst = Wb + W_GO; }
            else if (m < 12) { Wp = as_global(ap->in[12]) + (size_t)(m - 8) * 1024 * 4096; ldw = 4096; K = 1024; ncols = 4096; dst = Wb + W_UP + (size_t)(m - 8) * 4096 * 1024; }
            else             { Wp = as_global(ap->in[13]) + (size_t)(m - 12) * 4096 * 1024; ldw = 1024; K = 4096; ncols = 1024; dst = Wb + W_DN + (size_t)(m - 12) * 1024 * 4096; }
            const float* gn = as_global(ap->in[1]);
            const float* gk = (m < 2) ? gn + (size_t)(3 * m * 4) * D : (m == 4) ? gn + (size_t)(1 * 4) * D : (m == 6) ? gn + (size_t)(2 * 4) * D : (m >= 8 && m < 12) ? gn + (size_t)((m - 8) * 4 + 2) * D : nullptr;
            transpose_item(Wp, ldw, K, ncols / 32, dst, scr, r, lane, gk, (m < 2) ? 1024 : 0);
        }
        { const float* win = as_global(ap->in[7]); const float* wgu = as_global(ap->in[8]); const float* g2 = as_global(ap->in[1]) + (size_t)(2 * 4) * D;
        for (int it = gw; it < 1024; it += NGW) {
            const int cb = it >> 7, kb = it & 127, c = 64 * cb + lane;
            float wu[16];
#pragma unroll
            for (int r = 0; r < 16; ++r) wu[r] = wgu[r * 512 + c];
            float acc8[8];
#pragma unroll
            for (int kk = 0; kk < 8; ++kk) { const float* ar = win + (size_t)(8 * kb + kk) * 3088 + 3072; float s = 0.f;
#pragma unroll
                for (int r = 0; r < 16; ++r) s += ar[r] * wu[r];
                acc8[kk] = s * g2[8 * kb + kk]; }
            v4u o; o.x = pk2(acc8[0], acc8[1]); o.y = pk2(acc8[2], acc8[3]); o.z = pk2(acc8[4], acc8[5]); o.w = pk2(acc8[6], acc8[7]);
            *(v4u*)(Wb + W_GIN + (size_t)(3072 + c) * 1024 + 8 * kb) = o;
        } }
        resid_pass<true, false, false>(as_global(ap->in[0]), nullptr, nullptr, HB, nullptr, rh, gw, NGW, lane);
    }
    if (IN(0) && 1 < st_hi) xcd_barrier(xbar);
    if (st_hi > 1000000) grid.sync();
    run_layer<0>(a_args, lds, st_lo, st_hi, xbar);
    run_layer<1>(a_args, lds, st_lo, st_hi, xbar);
    run_layer<2>(a_args, lds, st_lo, st_hi, xbar);
    run_layer<3>(a_args, lds, st_lo, st_hi, xbar);
}

extern "C" void kernel_launch(void* const* d_in, const int* in_sizes, int n_in, void* d_out, int out_size, void* d_ws, size_t ws_size, hipStream_t stream) {
    static int grid = 0;
    if (grid == 0) {
        if (n_in != 14 || in_sizes[0] != T * D || out_size != T * D || ws_size < WS_END) { fprintf(stderr, "kernel_launch: unexpected shapes (n_in %d, in0 %d, out %d, ws %zu need %zu)\n", n_in, n_in > 0 ? in_sizes[0] : -1, out_size, ws_size, (size_t)WS_END); grid = -1; return; }
        int dev = 0, cus = 0, per_cu = 0;
        if (hipGetDevice(&dev) != hipSuccess || hipDeviceGetAttribute(&cus, hipDeviceAttributeMultiprocessorCount, dev) != hipSuccess) { fprintf(stderr, "kernel_launch: device query failed\n"); grid = -1; return; }
        if (hipFuncSetAttribute((const void*)mega_fwd, hipFuncAttributeMaxDynamicSharedMemorySize, LDS_BYTES) != hipSuccess) { fprintf(stderr, "kernel_launch: hipFuncSetAttribute failed\n"); grid = -1; return; }
        if (hipOccupancyMaxActiveBlocksPerMultiprocessor(&per_cu, (const void*)mega_fwd, NTHR, LDS_BYTES) != hipSuccess || per_cu < 1) { fprintf(stderr, "kernel_launch: occupancy query says %d\n", per_cu); per_cu = 1; }
        (void)hipGetLastError();
        grid = cus * per_cu;
    }
    if (grid < 0) return;
    Args a{};
    for (int i = 0; i < 14; ++i) a.in[i] = (const float*)d_in[i];
    a.out = (float*)d_out; a.ws = (unsigned char*)d_ws;
#if MK_COOP
    if (hipMemsetAsync((char*)d_ws + WS_BAR, 0, 16384, stream) != hipSuccess) { fprintf(stderr, "kernel_launch: memset failed\n"); return; }
    a.st_lo = 0; a.st_hi = NSTEPS; a.coop = 1;
    void* args[] = {&a};
    hipError_t e = hipLaunchCooperativeKernel((const void*)mega_fwd, dim3(grid), dim3(NTHR), args, LDS_BYTES, stream);
    if (e != hipSuccess) fprintf(stderr, "kernel_launch: cooperative launch failed: %s (grid %d)\n", hipGetErrorString(e), grid);
#else
    for (int st = 0; st < NSTEPS; ++st) { if (!step_active(st)) continue;
        a.st_lo = st; a.st_hi = st + 1; a.coop = 0;
        hipLaunchKernelGGL(mega_fwd, dim3(grid), dim3(NTHR), LDS_BYTES, stream, a); }
#endif
}
```
